# Optimizing an MI355X kernel written in HIP

```python
import jax, jax.numpy as jnp
from jax import lax
import numpy as np

D_MODEL = 1024
BATCH = 16
SEQ = 2048
DEPTH = 1

D_FF = 2816
PLE_DIM = 256
HG_HEADS = 4
HG_KDIM = 128
HG_VDIM = 128
HG_FDIM = HG_HEADS * HG_KDIM
HG_WIDTH = HG_HEADS * HG_VDIM
CHUNK = 64
MLA_HEADS = 4
Q_LORA = 256
KV_LORA = 128
NOPE_DIM = 128
ROPE_DIM = 64
V_DIM = 128
QK_DIM = NOPE_DIM + ROPE_DIM
MLA_WIDTH = MLA_HEADS * V_DIM
QBLOCK = 128
ROPE_THETA = 10000.0
MIX_WIDTH = HG_WIDTH + MLA_WIDTH
IN_SIZES = (HG_FDIM, HG_FDIM, HG_WIDTH, HG_WIDTH, Q_LORA, KV_LORA, ROPE_DIM)
IN_WIDTH = sum(IN_SIZES)
EPS = 1e-6

kernel_name = "hymba_hgrn2_mla_macaron_ple"


def rms_norm(x, g):
    xf = x.astype(jnp.float32)
    y = xf * lax.rsqrt(jnp.mean(xf * xf, axis=-1, keepdims=True) + EPS)
    return (y * g.astype(jnp.float32)).astype(x.dtype)


def swiglu(x, w_gate, w_up, w_down):
    return (jax.nn.silu(x @ w_gate) * (x @ w_up)) @ w_down


def apply_rope(x, cos, sin):
    x1, x2 = jnp.split(x.astype(jnp.float32), 2, axis=-1)
    return jnp.concatenate([x1 * cos - x2 * sin, x2 * cos + x1 * sin], axis=-1).astype(x.dtype)


def hgrn2_chunkwise(q, log_f, k, v):
    B, S, H, DK = q.shape
    DV = v.shape[-1]
    n_chunks = S // CHUNK

    def to_chunks(t):
        return t.reshape(B, n_chunks, CHUNK, H, t.shape[-1]).transpose(1, 0, 3, 2, 4)

    causal = jnp.tril(jnp.ones((CHUNK, CHUNK), dtype=bool))[:, :, None]

    def step(state, inp):
        q_c, g_c, k_c, v_c = inp
        b = jnp.cumsum(g_c, axis=2)
        diff = b[:, :, :, None, :] - b[:, :, None, :, :]
        decay = jnp.exp(jnp.where(causal, diff, -jnp.inf))
        scores = jnp.einsum('bhtd,bhsd,bhtsd->bhts', q_c, k_c, decay)
        o = (jnp.einsum('bhts,bhsv->bhtv', scores, v_c)
             + jnp.einsum('bhtd,bhdv->bhtv', q_c * jnp.exp(b), state))
        b_last = b[:, :, -1:, :]
        state = (state * jnp.exp(b_last)[:, :, 0, :, None]
                 + jnp.einsum('bhsd,bhsv->bhdv', k_c * jnp.exp(b_last - b), v_c))
        return state, o

    s0 = jnp.zeros((B, H, DK, DV), jnp.float32)
    _, o = lax.scan(step, s0, tuple(map(to_chunks, (q, log_f, k, v))))
    return o.transpose(1, 0, 3, 2, 4).reshape(B, S, H, DV)


def causal_block_attention(q, k, v):
    S = q.shape[2]
    scale = QK_DIM ** -0.5
    outs = []
    for j in range(S // QBLOCK):
        lo, hi = j * QBLOCK, (j + 1) * QBLOCK
        s = jnp.einsum('bhqd,bhkd->bhqk', q[:, :, lo:hi], k[:, :, :hi]).astype(jnp.float32) * scale
        mask = (lo + jnp.arange(QBLOCK))[:, None] >= jnp.arange(hi)[None, :]
        s = jnp.where(mask, s, -jnp.inf)
        pr = jax.nn.softmax(s, axis=-1).astype(v.dtype)
        outs.append(jnp.einsum('bhqk,bhkv->bhqv', pr, v[:, :, :hi]))
    return jnp.concatenate(outs, axis=2)


def setup_inputs(seed: int = 0) -> dict:
    key = jax.random.key(seed)
    ks = jax.random.split(key, 24)

    def w(k, shape, fan_in):
        return jax.random.normal(k, shape, jnp.float32) * fan_in ** -0.5

    def gain(k, shape):
        return 1.0 + 0.02 * jax.random.normal(k, shape, jnp.float32)

    offsets = jax.random.randint(ks[2], (BATCH, 1), 0, 1024, dtype=jnp.int32)
    positions = offsets + jnp.arange(SEQ, dtype=jnp.int32)[None, :]
    return {
        "x": jax.random.normal(ks[0], (BATCH, SEQ, D_MODEL), jnp.float32),
        "p": jax.random.normal(ks[1], (DEPTH, BATCH, SEQ, PLE_DIM), jnp.float32),
        "positions": positions,
        "ln_ffn1": gain(ks[3], (DEPTH, D_MODEL)),
        "w1_gate": w(ks[4], (DEPTH, D_MODEL, D_FF), D_MODEL),
        "w1_up": w(ks[5], (DEPTH, D_MODEL, D_FF), D_MODEL),
        "w1_down": w(ks[6], (DEPTH, D_FF, D_MODEL), D_FF),
        "ln_mix": gain(ks[7], (DEPTH, D_MODEL)),
        "w_in": w(ks[8], (DEPTH, D_MODEL, IN_WIDTH), D_MODEL),
        "hg_lb_logits": 0.5 * jax.random.normal(ks[9], (DEPTH + 1, HG_FDIM), jnp.float32),
        "hg_out_norm": gain(ks[10], (DEPTH, HG_HEADS, HG_VDIM)),
        "q_a_norm": gain(ks[11], (DEPTH, Q_LORA)),
        "w_q_up": w(ks[12], (DEPTH, Q_LORA, MLA_HEADS * QK_DIM), Q_LORA),
        "kv_a_norm": gain(ks[13], (DEPTH, KV_LORA)),
        "w_kv_up": w(ks[14], (DEPTH, KV_LORA, MLA_HEADS * (NOPE_DIM + V_DIM)), KV_LORA),
        "w_out": w(ks[15], (DEPTH, MIX_WIDTH, D_MODEL), MIX_WIDTH),
        "ln_ffn2": gain(ks[16], (DEPTH, D_MODEL)),
        "w2_gate": w(ks[17], (DEPTH, D_MODEL, D_FF), D_MODEL),
        "w2_up": w(ks[18], (DEPTH, D_MODEL, D_FF), D_MODEL),
        "w2_down": w(ks[19], (DEPTH, D_FF, D_MODEL), D_FF),
        "ln_ple": gain(ks[20], (DEPTH, D_MODEL)),
        "w_ple_gate": w(ks[21], (DEPTH, D_MODEL, D_MODEL), D_MODEL),
        "w_ple_proj": w(ks[22], (DEPTH, PLE_DIM, D_MODEL), PLE_DIM),
        "ln_final": gain(ks[23], (D_MODEL,)),
    }


def reference(x, p, positions, ln_ffn1, w1_gate, w1_up, w1_down, ln_mix, w_in,
              hg_lb_logits, hg_out_norm, q_a_norm, w_q_up, kv_a_norm, w_kv_up, w_out,
              ln_ffn2, w2_gate, w2_up, w2_down, ln_ple, w_ple_gate, w_ple_proj, ln_final):
    B, S, _ = x.shape
    split_at = [int(v) for v in np.cumsum(IN_SIZES)[:-1]]

    lower_bounds = jnp.cumsum(jax.nn.softmax(hg_lb_logits.astype(jnp.float32), axis=0), axis=0)

    half = ROPE_DIM // 2
    inv_freq = ROPE_THETA ** (-jnp.arange(half, dtype=jnp.float32) / half)
    ang = positions.astype(jnp.float32)[..., None] * inv_freq
    cos, sin = jnp.cos(ang), jnp.sin(ang)

    h = x
    for i in range(DEPTH):
        h = h + 0.5 * swiglu(rms_norm(h, ln_ffn1[i]), w1_gate[i], w1_up[i], w1_down[i])

        u = rms_norm(h, ln_mix[i]) @ w_in[i]
        hq, hf, hi_, hg, cq, ckv, kr = jnp.split(u, split_at, axis=-1)

        lb = lower_bounds[i]
        f_raw = hf.astype(jnp.float32)
        log_f = jnp.log(lb + (1.0 - lb) * jax.nn.sigmoid(f_raw))
        k_in = (1.0 - lb) * jax.nn.sigmoid(-f_raw)
        o_hg = hgrn2_chunkwise(
            hq.astype(jnp.float32).reshape(B, S, HG_HEADS, HG_KDIM),
            log_f.reshape(B, S, HG_HEADS, HG_KDIM),
            k_in.reshape(B, S, HG_HEADS, HG_KDIM),
            hi_.astype(jnp.float32).reshape(B, S, HG_HEADS, HG_VDIM)).astype(h.dtype)
        o_hg = rms_norm(o_hg, hg_out_norm[i]).reshape(B, S, HG_WIDTH) * jax.nn.silu(hg)

        q = (rms_norm(cq, q_a_norm[i]) @ w_q_up[i]).reshape(B, S, MLA_HEADS, QK_DIM)
        q_nope, q_rope = jnp.split(q, [NOPE_DIM], axis=-1)
        q_rope = apply_rope(q_rope, cos[:, :, None, :], sin[:, :, None, :])
        kv = (rms_norm(ckv, kv_a_norm[i]) @ w_kv_up[i]).reshape(B, S, MLA_HEADS, NOPE_DIM + V_DIM)
        k_nope, v = jnp.split(kv, [NOPE_DIM], axis=-1)
        k_rope = apply_rope(kr, cos, sin)
        k_rope = jnp.broadcast_to(k_rope[:, :, None, :], (B, S, MLA_HEADS, ROPE_DIM))
        qf = jnp.concatenate([q_nope, q_rope], axis=-1).transpose(0, 2, 1, 3)
        kf = jnp.concatenate([k_nope, k_rope], axis=-1).transpose(0, 2, 1, 3)
        o_mla = causal_block_attention(qf, kf, v.transpose(0, 2, 1, 3))
        o_mla = o_mla.transpose(0, 2, 1, 3).reshape(B, S, MLA_WIDTH)

        h = h + jnp.concatenate([o_hg, o_mla], axis=-1) @ w_out[i]

        h = h + 0.5 * swiglu(rms_norm(h, ln_ffn2[i]), w2_gate[i], w2_up[i], w2_down[i])

        gate = jax.nn.sigmoid(rms_norm(h, ln_ple[i]) @ w_ple_gate[i])
        h = h + gate * (p[i].astype(h.dtype) @ w_ple_proj[i])

    return rms_norm(h, ln_final)
```

```cpp
#include <hip/hip_runtime.h>
#include <hip/hip_cooperative_groups.h>
#include <cstdio>
#define N_LAUNCH 1
#ifndef PROBE_REP
#define PROBE_REP -1
#endif


namespace cg = cooperative_groups;

typedef unsigned short bf16_t;
typedef short bf16x8 __attribute__((ext_vector_type(8)));
typedef float f32x4 __attribute__((ext_vector_type(4)));
typedef float f32x2 __attribute__((ext_vector_type(2)));
typedef unsigned u32x2 __attribute__((ext_vector_type(2)));
typedef unsigned u32x4 __attribute__((ext_vector_type(4)));

constexpr int T = 32768, DM = 1024, DFF = 2816, SEQ = 2048;
constexpr int BM = 256, BK = 64, HALF = 128, HT = HALF * BK, NXCD = 8, WGM = 8;
constexpr int LDS_STAGE = 8 * HT * 2;
constexpr int LDS_TR = LDS_STAGE + 64;
constexpr int LDS_BYTES = LDS_TR + 8 * 2304;

__device__ const double INVF_REV[32] = {
0.15915494309189535, 0.11934937021124886, 0.08949940160889101, 0.06711508300522726, 0.050329212104487035, 0.03774158471741977, 0.0283021958306234, 0.02122365276477766, 0.015915494309189534, 0.011934937021124886, 0.008949940160889102, 0.006711508300522725, 0.005032921210448704, 0.003774158471741977, 0.00283021958306234, 0.0021223652764777662, 0.0015915494309189536, 0.0011934937021124885, 0.0008949940160889102, 0.0006711508300522726, 0.0005032921210448703, 0.00037741584717419774, 0.00028302195830623395, 0.0002122365276477766, 0.00015915494309189535, 0.00011934937021124886, 8.949940160889102e-05, 6.711508300522725e-05, 5.0329212104487035e-05, 3.774158471741978e-05, 2.8302195830623396e-05, 2.122365276477766e-05};

struct Params {
  const float *x, *p; const int* pos;
  const float *ln_ffn1, *w1g, *w1u, *w1d, *ln_mix, *w_in, *lb_logits, *hg_norm, *q_a_norm, *w_q_up, *kv_a_norm, *w_kv_up,
              *w_out, *ln_ffn2, *w2g, *w2u, *w2d, *ln_ple, *w_pg, *w_pp, *ln_final;
  float* out;
  char* ws;
  int ph_lo, ph_hi;
};
constexpr size_t MiB = 1024 * 1024;
constexpr size_t OFF_hb = 0,   OFF_act = 64 * MiB, OFF_Kb = OFF_act, OFF_Vt = OFF_act + 48 * MiB, OFF_cqb = OFF_act + 80 * MiB,
                 OFF_ckvb = OFF_act + 96 * MiB, OFF_sg = OFF_act + 112 * MiB, OFF_vhT = OFF_act + 144 * MiB, OFF_qh = 240 * MiB,
                 OFF_logf = 272 * MiB, OFF_pp = OFF_logf, OFF_pb = 336 * MiB, OFF_cc = 352 * MiB,
                 OFF_W1cat = 416 * MiB, OFF_Wd1t = OFF_W1cat + 11 * MiB, OFF_Wint = OFF_Wd1t + 5632 * 1024, OFF_Wqt = OFF_Wint + 5 * MiB,
                 OFF_Wkvt = OFF_Wqt + 384 * 1024, OFF_Woutt = OFF_Wkvt + 512 * 1024, OFF_W2cat = OFF_Woutt + 2 * MiB, OFF_Wd2t = OFF_W2cat + 11 * MiB,
                 OFF_Wpgt = OFF_Wd2t + 5632 * 1024, OFF_Wppt = OFF_Wpgt + 2 * MiB, OFF_cs = 460 * MiB, OFF_lb = 468 * MiB,
                 OFF_ssq1 = OFF_lb + 64 * 1024, OFF_ssq2 = OFF_ssq1 + 128 * 1024, OFF_ssq3 = OFF_ssq2 + 128 * 1024, OFF_ssq4 = OFF_ssq3 + 128 * 1024,
                 OFF_ssq5 = OFF_ssq4 + 128 * 1024, OFF_ssq_q = OFF_ssq5 + 128 * 1024, OFF_ssq_kv = OFF_ssq_q + 128 * 1024, OFF_ctr = OFF_ssq_kv + 128 * 1024, OFF_pcnt = OFF_ctr + 256, OFF_bar = OFF_pcnt + 768, OFF_ktt = 470 * MiB, OFF_elast = OFF_ktt + 32 * MiB, WS_END = OFF_elast + MiB;
static_assert(OFF_bar + 16384 <= OFF_ktt, "barrier words overlap ktt");
static_assert(OFF_Wppt + 512 * 1024 <= OFF_cs, "weights overlap cs");

typedef __attribute__((address_space(1))) char GCHAR;
extern __shared__ __attribute__((aligned(16))) char smem[];

__device__ __forceinline__ int tid_l() { int t = threadIdx.x; asm volatile("" : "+v"(t)); return t; }
typedef __bf16 bf16v2_t __attribute__((ext_vector_type(2)));
__device__ __forceinline__ unsigned cvt_pk(float lo, float hi) { f32x2 v = {lo, hi}; bf16v2_t r = __builtin_convertvector(v, bf16v2_t); return __builtin_bit_cast(unsigned, r); }
__device__ __forceinline__ float bf2f(unsigned short v) { return __uint_as_float(((unsigned)v) << 16); }
__device__ __forceinline__ float sigmoidf_(float x) { return __builtin_amdgcn_rcpf(1.0f + __expf(-x)); }
__device__ __forceinline__ void atomic_addf(float* p, float v) { __hip_atomic_fetch_add(p, v, __ATOMIC_RELAXED, __HIP_MEMORY_SCOPE_SYSTEM); }

__device__ __forceinline__ int perm32(int rho) { const int n = rho >> 4, i = rho & 15; return 8 * (i >> 2) + 4 * n + (i & 3); }
__device__ __forceinline__ int perm_src(int perm, int n, int& which) {
  which = 0;
  if (perm == 0) return n;
  if (perm == 1) { int pn = n >> 8, bj = (n >> 7) & 1, c = n & 127; which = bj; return pn * 128 + (c & ~31) + perm32(c & 31); }
  if (perm == 4) return (n & ~31) + perm32(n & 31);
  if (perm == 2) { if (n < 2432) return n; if (n < 2496) { int c = n - 2432; return 2432 + (c >> 1) + 32 * (c & 1); } return -1; }
    { if (n < 512) { int h = n >> 7, c = n & 127; return h * 192 + c; } int r = n - 512, h = r >> 6, c = r & 63; return h * 192 + 128 + (c >> 1) + 32 * (c & 1); }
}

__device__ __forceinline__ void prep_weight(const float* __restrict__ W, const float* __restrict__ W2, const float* __restrict__ gain, bf16_t* __restrict__ dst,
                                            const int Ksrc, const int Nsrc, const int Kd, const int Nd, const int perm, const int first, const int stride) {
  const int ntask = Nd * (Kd >> 3);
  for (int t = first; t < ntask; t += stride) {
    const int n = t % Nd, kc = t / Nd;
    int which; const int src = perm_src(perm, n, which);
    const float* Ws = which ? W2 : W;
    float v[8];
#pragma unroll
    for (int i = 0; i < 8; ++i) {
      const int k = kc * 8 + i;
      v[i] = (src >= 0 && k < Ksrc) ? Ws[(size_t)k * Nsrc + src] : 0.f;
    }
    if (gain) {
#pragma unroll
      for (int i = 0; i < 8; ++i) { const int k = kc * 8 + i; if (k < Ksrc) v[i] *= gain[k]; }
    }
    u32x4 o = {cvt_pk(v[0], v[1]), cvt_pk(v[2], v[3]), cvt_pk(v[4], v[5]), cvt_pk(v[6], v[7])};
    *(u32x4*)(dst + (size_t)n * Kd + kc * 8) = o;
  }
}

__device__ __forceinline__ void prep_x(const Params& P, GCHAR* ws_) {
  const int tid = tid_l(), lane = tid & 63, wid = tid >> 6;
  for (int row = (blockIdx.x * 8 + wid) * 2; row < T; row += gridDim.x * 16) {
    f32x4 v[2][4];
#pragma unroll
    for (int r = 0; r < 2; ++r)
#pragma unroll
      for (int i = 0; i < 4; ++i) v[r][i] = *(const f32x4*)(P.x + (size_t)(row + r) * DM + i * 256 + lane * 4);
#pragma unroll
    for (int r = 0; r < 2; ++r) {
      float sq = 0.f;
#pragma unroll
      for (int i = 0; i < 4; ++i) {
        sq += v[r][i][0] * v[r][i][0] + v[r][i][1] * v[r][i][1] + v[r][i][2] * v[r][i][2] + v[r][i][3] * v[r][i][3];
        u32x2 o = {cvt_pk(v[r][i][0], v[r][i][1]), cvt_pk(v[r][i][2], v[r][i][3])};
        *(u32x2*)(((bf16_t*)(ws_ + OFF_hb)) + (size_t)(row + r) * DM + i * 256 + lane * 4) = o;
      }
#pragma unroll
      for (int o = 32; o >= 1; o >>= 1) sq += __shfl_xor(sq, o);
      if (lane == 0) ((float*)(ws_ + OFF_ssq1))[row + r] = sq;
    }
  }
}

__device__ __forceinline__ void prep_weights(const Params& P, GCHAR* ws_) {
  const int first = blockIdx.x * 512 + tid_l(), stride = gridDim.x * 512;
  prep_weight(P.w1g, P.w1u, P.ln_ffn1, ((bf16_t*)(ws_ + OFF_W1cat)), 1024, 2816, 1024, 5632, 1, first, stride);
  prep_weight(P.w1d, nullptr, nullptr, ((bf16_t*)(ws_ + OFF_Wd1t)), 2816, 1024, 2816, 1024, 4, first, stride);
  prep_weight(P.w_in, nullptr, P.ln_mix, ((bf16_t*)(ws_ + OFF_Wint)), 1024, 2496, 1024, 2560, 2, first, stride);
  prep_weight(P.w_q_up, nullptr, P.q_a_norm, ((bf16_t*)(ws_ + OFF_Wqt)), 256, 768, 256, 768, 3, first, stride);
  prep_weight(P.w_kv_up, nullptr, P.kv_a_norm, ((bf16_t*)(ws_ + OFF_Wkvt)), 128, 1024, 256, 1024, 0, first, stride);
  prep_weight(P.w_out, nullptr, nullptr, ((bf16_t*)(ws_ + OFF_Woutt)), 1024, 1024, 1024, 1024, 4, first, stride);
  prep_weight(P.w2g, P.w2u, P.ln_ffn2, ((bf16_t*)(ws_ + OFF_W2cat)), 1024, 2816, 1024, 5632, 1, first, stride);
  prep_weight(P.w2d, nullptr, nullptr, ((bf16_t*)(ws_ + OFF_Wd2t)), 2816, 1024, 2816, 1024, 4, first, stride);
  prep_weight(P.w_pg, nullptr, P.ln_ple, ((bf16_t*)(ws_ + OFF_Wpgt)), 1024, 1024, 1024, 1024, 4, first, stride);
  prep_weight(P.w_pp, nullptr, nullptr, ((bf16_t*)(ws_ + OFF_Wppt)), 256, 1024, 256, 1024, 0, first, stride);
}

__device__ __forceinline__ void phase0(const Params& P) {
  GCHAR* ws_ = (GCHAR*)P.ws; asm volatile("" : "+s"(ws_));
  const int tid = tid_l();
  const int gthreads = gridDim.x * 512, gtid = blockIdx.x * 512 + tid;
  for (int i = gtid; i < 6 * T / 4 + 64; i += gthreads) ((f32x4*)((float*)(ws_ + OFF_ssq2)))[i] = (f32x4){0.f, 0.f, 0.f, 0.f};
  if (gtid < 512) { float l0 = P.lb_logits[gtid], l1 = P.lb_logits[512 + gtid]; ((float*)(ws_ + OFF_lb))[gtid] = 1.f / (1.f + __expf(l1 - l0)); }
  for (int i = gtid; i < T * 32; i += gthreads) {
    const int t = i >> 5, f = i & 31;
    double a = (double)P.pos[t] * INVF_REV[f];
    a -= rint(a);
    const float fr = (float)a;
    f32x2 o = {__builtin_amdgcn_cosf(fr), __builtin_amdgcn_sinf(fr)};
    ((f32x2*)(ws_ + OFF_cs))[i] = o;
  }
  for (int i = gtid; i < T * 256 / 4; i += 4 * gthreads) {
    f32x4 v[4];
#pragma unroll
    for (int u = 0; u < 4; ++u) v[u] = (i + u * gthreads < T * 256 / 4) ? ((const f32x4*)P.p)[i + u * gthreads] : (f32x4){0.f, 0.f, 0.f, 0.f};
#pragma unroll
    for (int u = 0; u < 4; ++u)
      if (i + u * gthreads < T * 256 / 4) { u32x2 o = {cvt_pk(v[u][0], v[u][1]), cvt_pk(v[u][2], v[u][3])}; ((u32x2*)((bf16_t*)(ws_ + OFF_pb)))[i + u * gthreads] = o; }
  }
  if (blockIdx.x & 1) { prep_weights(P, ws_); prep_x(P, ws_); }
  else { prep_x(P, ws_); prep_weights(P, ws_); }
}

__device__ __forceinline__ int lds_byte(int r, int c) {
  int st = (r >> 4) * 2 + (c >> 5), rr = r & 15, cc = c & 31, ob = rr * 64 + cc * 2;
  return st * 1024 + (ob ^ (((ob >> 9) & 1) << 5));
}
__device__ __forceinline__ void stage_rc(int b, int& R, int& C) {
  int st = b / 1024, sb = b % 1024, swz = sb ^ (((sb >> 9) & 1) << 5);
  R = (st >> 1) * 16 + swz / 64; C = (st & 1) * 32 + (swz % 64) / 2;
}

enum { M_SWIGLU = 0, M_RESID = 1, M_WIN = 2, M_QUP = 3, M_KVUP = 4, M_PP = 5, M_PLE = 6 };

struct GemmJob { const bf16_t* A; const bf16_t* Bt; int K; int nN; int mode; int aux; };

#define EPI_GEO const int tid_ = tid_l(); const int wid = __builtin_amdgcn_readfirstlane(tid_ >> 6), lane = tid_ & 63, wr = wid >> 2, wc = wid & 3; int fr = lane & 15, fq = lane >> 4; asm volatile("" : "+v"(fr), "+v"(fq)); (void)wc; (void)wr;

#define LOAD_RS8(invn) float rs8[8]; _Pragma("unroll") for (int r_ = 0; r_ < 8; ++r_) rs8[r_] = rsqrtf(rsraw[r_] * (invn) + 1e-6f);

__device__ __forceinline__ void store_bf4(bf16_t* p, f32x4 v) { u32x2 o = {cvt_pk(v[0], v[1]), cvt_pk(v[2], v[3])}; *(u32x2*)p = o; }


__device__ __forceinline__ void store_tr16(char* wl, const f32x4 (&v)[4], bf16_t* dst, const size_t ld, const int fr, const int fq, const int lane) {
#pragma unroll
  for (int m = 0; m < 4; ++m) {
    const unsigned p0 = cvt_pk(v[m][0], v[m][1]), p1 = cvt_pk(v[m][2], v[m][3]);
    char* w = wl + (fq * 4) * 144 + (m * 16 + fr) * 2;
    *(bf16_t*)(w) = (bf16_t)(p0 & 0xffffu); *(bf16_t*)(w + 144) = (bf16_t)(p0 >> 16);
    *(bf16_t*)(w + 288) = (bf16_t)(p1 & 0xffffu); *(bf16_t*)(w + 432) = (bf16_t)(p1 >> 16);
  }
  asm volatile("s_waitcnt lgkmcnt(0)" ::: "memory");
#pragma unroll
  for (int k = 0; k < 2; ++k) {
    const int chunk = lane + k * 64, col = chunk >> 3, r8 = chunk & 7;
    const u32x4 t = *(const u32x4*)(wl + col * 144 + r8 * 16);
    *(u32x4*)(dst + (size_t)col * ld + r8 * 8) = t;
  }
  asm volatile("s_waitcnt lgkmcnt(0)" ::: "memory");
}

__device__ __forceinline__ void store_bf8(bf16_t* p, f32x4 a, f32x4 b) { u32x4 o = {cvt_pk(a[0], a[1]), cvt_pk(a[2], a[3]), cvt_pk(b[0], b[1]), cvt_pk(b[2], b[3])}; *(u32x4*)p = o; }
__device__ __forceinline__ f32x4 bf_lo4(u32x4 v) { f32x4 r; r[0] = __uint_as_float(v[0] << 16); r[1] = __uint_as_float(v[0] & 0xffff0000u); r[2] = __uint_as_float(v[1] << 16); r[3] = __uint_as_float(v[1] & 0xffff0000u); return r; }
__device__ __forceinline__ f32x4 bf_hi4(u32x4 v) { f32x4 r; r[0] = __uint_as_float(v[2] << 16); r[1] = __uint_as_float(v[2] & 0xffff0000u); r[2] = __uint_as_float(v[3] << 16); r[3] = __uint_as_float(v[3] & 0xffff0000u); return r; }

__device__ __forceinline__ void epi_swiglu(const f32x4 (&acc)[2][2][4][2], int brow, int pn, const float (&rsraw)[8], bf16_t* __restrict__ act) {
  EPI_GEO
  LOAD_RS8(1.f / 1024.f)
#pragma unroll
  for (int ai = 0; ai < 2; ++ai)
#pragma unroll
    for (int m = 0; m < 4; ++m) {
      const int row = brow + ai * 128 + wr * 64 + m * 16 + fr;
      const float rs = rs8[ai * 4 + m];
      f32x4 a[2];
#pragma unroll
      for (int n = 0; n < 2; ++n) {
        const f32x4 g = acc[ai][0][m][n] * rs, u = acc[ai][1][m][n] * rs;
#pragma unroll
        for (int j = 0; j < 4; ++j) a[n][j] = g[j] * sigmoidf_(g[j]) * u[j];
      }
      store_bf8(act + (size_t)row * DFF + pn * 128 + wc * 32 + 8 * fq, a[0], a[1]);
    }
}

__device__ __forceinline__ f32x4 bf4_to_f32(u32x2 v) {
  f32x4 r; r[0] = __uint_as_float(v[0] << 16); r[1] = __uint_as_float(v[0] & 0xffff0000u); r[2] = __uint_as_float(v[1] << 16); r[3] = __uint_as_float(v[1] & 0xffff0000u); return r;
}
template <bool SRC_F32>
__device__ __forceinline__ void epi_resid(const f32x4 (&acc)[2][2][4][2], int brow, int bcol, const float* xsrc, float alpha, bf16_t* hb, float* ssq_next) {
  EPI_GEO
  const size_t base = (size_t)(brow + wr * 64 + fr) * DM + bcol + wc * 32 + 8 * fq;
  f32x4 cur[2][2], nxt[2][2];
#define RESID_LD(dst, off_) _Pragma("unroll") for (int bj = 0; bj < 2; ++bj) { \
    if (SRC_F32) { dst[bj][0] = *(const f32x4*)(xsrc + (off_) + bj * 128); dst[bj][1] = *(const f32x4*)(xsrc + (off_) + bj * 128 + 4); } \
    else { const u32x4 t_ = *(const u32x4*)(hb + (off_) + bj * 128); dst[bj][0] = bf_lo4(t_); dst[bj][1] = bf_hi4(t_); } }
  RESID_LD(cur, base);
#pragma unroll
  for (int r = 0; r < 8; ++r) {
    const int ai = r >> 2, m = r & 3;
    const size_t ro = base + (size_t)(ai * 128 + m * 16) * DM;
    if (r < 7) {
      const size_t rn = base + (size_t)(((r + 1) >> 2) * 128 + ((r + 1) & 3) * 16) * DM;
      RESID_LD(nxt, rn);
    }
    float sq = 0.f;
#pragma unroll
    for (int bj = 0; bj < 2; ++bj) {
      const f32x4 h0 = cur[bj][0] + acc[ai][bj][m][0] * alpha, h1 = cur[bj][1] + acc[ai][bj][m][1] * alpha;
      store_bf8(hb + ro + bj * 128, h0, h1);
      sq += h0[0] * h0[0] + h0[1] * h0[1] + h0[2] * h0[2] + h0[3] * h0[3] + h1[0] * h1[0] + h1[1] * h1[1] + h1[2] * h1[2] + h1[3] * h1[3];
    }
    sq += __shfl_xor(sq, 16); sq += __shfl_xor(sq, 32);
    if (fq == 0) atomic_addf(ssq_next + brow + ai * 128 + wr * 64 + m * 16 + fr, sq);
#pragma unroll
    for (int bj = 0; bj < 2; ++bj)
#pragma unroll
      for (int n = 0; n < 2; ++n) cur[bj][n] = nxt[bj][n];
  }
#undef RESID_LD
}

__device__ __forceinline__ void epi_ple(const f32x4 (&acc)[2][2][4][2], int brow, int bcol, const float (&rsraw)[8], const bf16_t* __restrict__ pp,
                                        const bf16_t* hbsrc, bf16_t* h4b, float* ssq_next) {
  EPI_GEO
  const size_t base = (size_t)(brow + wr * 64 + fr) * DM + bcol + wc * 32 + 8 * fq;
  u32x4 hc[2], hn[2], pc[2], pnx[2];
#pragma unroll
  for (int bj = 0; bj < 2; ++bj) { hc[bj] = *(const u32x4*)(hbsrc + base + bj * 128); pc[bj] = *(const u32x4*)(pp + base + bj * 128); }
#pragma unroll
  for (int r = 0; r < 8; ++r) {
    const int ai = r >> 2, m = r & 3;
    const size_t ro = base + (size_t)(ai * 128 + m * 16) * DM;
    if (r < 7) {
      const size_t rn = base + (size_t)(((r + 1) >> 2) * 128 + ((r + 1) & 3) * 16) * DM;
#pragma unroll
      for (int bj = 0; bj < 2; ++bj) { hn[bj] = *(const u32x4*)(hbsrc + rn + bj * 128); pnx[bj] = *(const u32x4*)(pp + rn + bj * 128); }
    }
    const float rs = rsqrtf(rsraw[r] * (1.f / 1024.f) + 1e-6f);
    float sq = 0.f;
#pragma unroll
    for (int bj = 0; bj < 2; ++bj) {
      f32x4 hv[2] = {bf_lo4(hc[bj]), bf_hi4(hc[bj])};
      const f32x4 pv[2] = {bf_lo4(pc[bj]), bf_hi4(pc[bj])};
#pragma unroll
      for (int n = 0; n < 2; ++n) {
        const f32x4 a = acc[ai][bj][m][n] * rs;
#pragma unroll
        for (int j = 0; j < 4; ++j) hv[n][j] += sigmoidf_(a[j]) * pv[n][j];
        sq += hv[n][0] * hv[n][0] + hv[n][1] * hv[n][1] + hv[n][2] * hv[n][2] + hv[n][3] * hv[n][3];
      }
      store_bf8(h4b + ro + bj * 128, hv[0], hv[1]);
    }
    sq += __shfl_xor(sq, 16); sq += __shfl_xor(sq, 32);
    if (fq == 0) atomic_addf(ssq_next + brow + ai * 128 + wr * 64 + m * 16 + fr, sq);
#pragma unroll
    for (int bj = 0; bj < 2; ++bj) { hc[bj] = hn[bj]; pc[bj] = pnx[bj]; }
  }
}

__device__ __forceinline__ void epi_pp(const f32x4 (&acc)[2][2][4][2], int brow, int bcol, bf16_t* __restrict__ pp) {
  EPI_GEO
#pragma unroll
  for (int ai = 0; ai < 2; ++ai)
#pragma unroll
    for (int m = 0; m < 4; ++m) {
      const int row = brow + ai * 128 + wr * 64 + m * 16 + fr;
#pragma unroll
      for (int bj = 0; bj < 2; ++bj)
#pragma unroll
        for (int n = 0; n < 2; ++n) store_bf4(pp + (size_t)row * DM + bcol + bj * 128 + wc * 32 + n * 16 + fq * 4, acc[ai][bj][m][n]);
    }
}

__device__ __forceinline__ void rope4(f32x4 v, f32x4 cs2, unsigned& o1, unsigned& o2) {
  const float a0 = v[0] * cs2[0] - v[1] * cs2[1], b0 = v[1] * cs2[0] + v[0] * cs2[1];
  const float a1 = v[2] * cs2[2] - v[3] * cs2[3], b1 = v[3] * cs2[2] + v[2] * cs2[3];
  o1 = cvt_pk(a0, a1); o2 = cvt_pk(b0, b1);
}

__device__ __forceinline__ void epi_win(const f32x4 (&acc)[2][2][4][2], int brow, int pn, const float (&rsraw)[8], const Params& P) {
  GCHAR* ws_ = (GCHAR*)P.ws; asm volatile("" : "+s"(ws_));
  EPI_GEO
  LOAD_RS8(1.f / 1024.f)
  if (pn == 4 || pn == 5) {
    char* wl = smem + LDS_TR + wid * 2304;
#pragma unroll
    for (int ai = 0; ai < 2; ++ai)
#pragma unroll
      for (int bj = 0; bj < 2; ++bj)
#pragma unroll
        for (int n = 0; n < 2; ++n) {
          f32x4 v[4];
#pragma unroll
          for (int m = 0; m < 4; ++m) v[m] = acc[ai][bj][m][n] * rs8[ai * 4 + m];
          const int col0 = (pn - 4) * 256 + bj * 128 + wc * 32 + n * 16, row0 = brow + ai * 128 + wr * 64;
          store_tr16(wl, v, ((bf16_t*)(ws_ + OFF_vhT)) + (size_t)col0 * T + row0, (size_t)T, fr, fq, lane);
        }
    return;
  }
  f32x4 lb4[2][2];
#pragma unroll
  for (int bj = 0; bj < 2; ++bj)
#pragma unroll
    for (int n = 0; n < 2; ++n)
      lb4[bj][n] = (pn == 2 || pn == 3) ? *(const f32x4*)(((float*)(ws_ + OFF_lb)) + (pn - 2) * 256 + bj * 128 + wc * 32 + n * 16 + fq * 4) : (f32x4){0.f, 0.f, 0.f, 0.f};
#pragma unroll
  for (int ai = 0; ai < 2; ++ai)
#pragma unroll
    for (int m = 0; m < 4; ++m) {
      const int row = brow + ai * 128 + wr * 64 + m * 16 + fr;
      const float rs = rs8[ai * 4 + m];
      float sq0 = 0.f;
#pragma unroll
      for (int bj = 0; bj < 2; ++bj)
#pragma unroll
        for (int n = 0; n < 2; ++n) {
          const int c = bj * 128 + wc * 32 + n * 16 + fq * 4;
          f32x4 v = acc[ai][bj][m][n] * rs;
          if (pn < 2) {
            store_bf4(((bf16_t*)(ws_ + OFF_qh)) + (size_t)row * 512 + pn * 256 + c, v);
          } else if (pn < 4) {
            const int d = (pn - 2) * 256 + c;
            const f32x4 lbv = lb4[bj][n]; f32x4 o;
#pragma unroll
            for (int j = 0; j < 4; ++j) o[j] = lbv[j] + (1.f - lbv[j]) * sigmoidf_(v[j]);
            *(f32x4*)(((float*)(ws_ + OFF_logf)) + (size_t)row * 512 + d) = o;
          } else if (pn < 8) {
            f32x4 o;
#pragma unroll
            for (int j = 0; j < 4; ++j) o[j] = v[j] * sigmoidf_(v[j]);
            store_bf4(((bf16_t*)(ws_ + OFF_sg)) + (size_t)row * 512 + (pn - 6) * 256 + c, o);
          } else if (pn == 8) {
            store_bf4(((bf16_t*)(ws_ + OFF_cqb)) + (size_t)row * 256 + c, v);
            sq0 += v[0] * v[0] + v[1] * v[1] + v[2] * v[2] + v[3] * v[3];
          } else {
            if (bj == 0) {
              store_bf4(((bf16_t*)(ws_ + OFF_ckvb)) + (size_t)row * 256 + c, v);
              sq0 += v[0] * v[0] + v[1] * v[1] + v[2] * v[2] + v[3] * v[3];
            } else {
              *(u32x2*)(((bf16_t*)(ws_ + OFF_ckvb)) + (size_t)row * 256 + c) = (u32x2){0u, 0u};
              if (wc < 2) {
                const int i0 = wc * 16 + n * 8 + fq * 2;
                f32x4 cs2 = *(const f32x4*)(((f32x2*)(ws_ + OFF_cs)) + (size_t)row * 32 + i0);
                unsigned o1, o2; rope4(v, cs2, o1, o2);
#pragma unroll
                for (int h = 0; h < 4; ++h) {
                  *(unsigned*)(((bf16_t*)(ws_ + OFF_Kb)) + (size_t)row * 768 + h * 192 + 128 + i0) = o1;
                  *(unsigned*)(((bf16_t*)(ws_ + OFF_Kb)) + (size_t)row * 768 + h * 192 + 160 + i0) = o2;
                }
              }
            }
          }
        }
      if (pn >= 8) {
        sq0 += __shfl_xor(sq0, 16); sq0 += __shfl_xor(sq0, 32);
        if (fq == 0) atomic_addf((pn == 8 ? ((float*)(ws_ + OFF_ssq_q)) : ((float*)(ws_ + OFF_ssq_kv))) + row, sq0);
      }
    }
}

__device__ __forceinline__ void epi_qup(const f32x4 (&acc)[2][2][4][2], int brow, int pn, const float (&rsraw)[8], const Params& P) {
  GCHAR* ws_ = (GCHAR*)P.ws; asm volatile("" : "+s"(ws_));
  EPI_GEO
  LOAD_RS8(1.f / 256.f)
  const float qscale = 0.07216878364870322f * 1.4426950408889634f;
#pragma unroll
  for (int ai = 0; ai < 2; ++ai)
#pragma unroll
    for (int m = 0; m < 4; ++m) {
      const int row = brow + ai * 128 + wr * 64 + m * 16 + fr;
      const float rs = rs8[ai * 4 + m] * qscale;
#pragma unroll
      for (int bj = 0; bj < 2; ++bj)
#pragma unroll
        for (int n = 0; n < 2; ++n) {
          f32x4 v = acc[ai][bj][m][n] * rs;
          if (pn < 2) {
            const int h = pn * 2 + bj, c = wc * 32 + n * 16 + fq * 4;
            store_bf4(((bf16_t*)P.out) + (size_t)row * 768 + h * 192 + c, v);
          } else {
            const int h = bj * 2 + (wc >> 1), i0 = (wc & 1) * 16 + n * 8 + fq * 2;
            f32x4 cs2 = *(const f32x4*)(((f32x2*)(ws_ + OFF_cs)) + (size_t)row * 32 + i0);
            unsigned o1, o2; rope4(v, cs2, o1, o2);
            *(unsigned*)(((bf16_t*)P.out) + (size_t)row * 768 + h * 192 + 128 + i0) = o1;
            *(unsigned*)(((bf16_t*)P.out) + (size_t)row * 768 + h * 192 + 160 + i0) = o2;
          }
        }
    }
}

__device__ __forceinline__ void epi_kvup(const f32x4 (&acc)[2][2][4][2], int brow, int pn, const float (&rsraw)[8], const Params& P) {
  GCHAR* ws_ = (GCHAR*)P.ws; asm volatile("" : "+s"(ws_));
  EPI_GEO
  const int brow_ = brow; (void)brow_;
  LOAD_RS8(1.f / 128.f)
  const int h = pn;
#pragma unroll
  for (int ai = 0; ai < 2; ++ai)
#pragma unroll
    for (int m = 0; m < 4; ++m) {
      {
        const int row = brow + ai * 128 + wr * 64 + m * 16 + fr;
        const float rs = rs8[ai * 4 + m];
#pragma unroll
        for (int n = 0; n < 2; ++n) store_bf4(((bf16_t*)(ws_ + OFF_Kb)) + (size_t)row * 768 + h * 192 + wc * 32 + n * 16 + fq * 4, acc[ai][0][m][n] * rs);
      }
    }
  {
    char* wl = smem + LDS_TR + wid * 2304;
#pragma unroll
    for (int ai = 0; ai < 2; ++ai)
#pragma unroll
      for (int n = 0; n < 2; ++n) {
        f32x4 v[4];
#pragma unroll
        for (int m = 0; m < 4; ++m) v[m] = acc[ai][1][m][n] * rs8[ai * 4 + m];
        const int row0 = brow + ai * 128 + wr * 64, b = row0 >> 11, sp0 = row0 & 2047, dv0 = wc * 32 + n * 16;
        store_tr16(wl, v, ((bf16_t*)(ws_ + OFF_Vt)) + ((size_t)(b * 4 + h) * 128 + dv0) * SEQ + sp0, (size_t)SEQ, fr, fq, lane);
      }
  }
}

__device__ __forceinline__ GemmJob mkjob(const bf16_t* A, const bf16_t* Bt, int K, int nN, int mode, int aux) { GemmJob j; j.A = A; j.Bt = Bt; j.K = K; j.nN = nN; j.mode = mode; j.aux = aux; return j; }


#define LAS __attribute__((address_space(3)))
struct Unit { const char* A; const char* B; int pm, pn, mode, aux; };

__device__ __forceinline__ bool next_unit(const GemmJob& j0, const GemmJob& j1, int i, Unit& u) {
  const int n0 = 128 * j0.nN, n1 = 128 * j1.nN;
  int l = i * (int)gridDim.x + (int)blockIdx.x;
  if (l >= n0 + n1) return false;
  const bool second = l >= n0;
  if (second) l -= n0;
  const int nN = second ? j1.nN : j0.nN;
  const int nM = 128, nwg = nM * nN;
  int wgid = l;
  { const int q = nwg / NXCD, r = nwg % NXCD, xcd = wgid % NXCD, off = wgid / NXCD; wgid = (xcd < r ? xcd * (q + 1) : r * (q + 1) + (xcd - r) * q) + off; }
  const int nig = WGM * nN, gid = wgid / nig, fm = gid * WGM, gsz = min(nM - fm, WGM);
  u.pm = fm + ((wgid % nig) % gsz); u.pn = (wgid % nig) / gsz;
  u.A = (const char*)(second ? j1.A : j0.A); u.B = (const char*)(second ? j1.Bt : j0.Bt);
  u.mode = second ? j1.mode : j0.mode; u.aux = second ? j1.aux : j0.aux;
  return true;
}

__device__ __forceinline__ void run_epilogue(const Params& P, const f32x4 (&acc)[2][2][4][2], const Unit& u, const float (&rsraw)[8]) {
  GCHAR* ws_ = (GCHAR*)P.ws; asm volatile("" : "+s"(ws_));
  const int brow = u.pm * BM, bcol = u.pn * BM, pn = u.pn;
  switch (u.mode) {
    case M_SWIGLU: epi_swiglu(acc, brow, pn, rsraw, ((bf16_t*)(ws_ + OFF_act))); break;
    case M_RESID:
      if (u.aux == 0) epi_resid<true>(acc, brow, bcol, P.x, 0.5f, ((bf16_t*)(ws_ + OFF_hb)), ((float*)(ws_ + OFF_ssq2)));
      else if (u.aux == 1) epi_resid<false>(acc, brow, bcol, nullptr, 1.0f, ((bf16_t*)(ws_ + OFF_hb)), ((float*)(ws_ + OFF_ssq3)));
      else epi_resid<false>(acc, brow, bcol, nullptr, 0.5f, ((bf16_t*)(ws_ + OFF_hb)), ((float*)(ws_ + OFF_ssq4)));
      break;
    case M_WIN: epi_win(acc, brow, pn, rsraw, P); break;
    case M_QUP: epi_qup(acc, brow, pn, rsraw, P); break;
    case M_KVUP: epi_kvup(acc, brow, pn, rsraw, P); break;
    case M_PP: epi_pp(acc, brow, bcol, ((bf16_t*)(ws_ + OFF_pp))); break;
    default: epi_ple(acc, brow, bcol, rsraw, ((bf16_t*)(ws_ + OFF_pp)), ((const bf16_t*)(ws_ + OFF_hb)), ((bf16_t*)(ws_ + OFF_cc)), ((float*)(ws_ + OFF_ssq5))); break;
  }
}

__device__ __forceinline__ void gemm_phase(const Params& P, const GemmJob j0, const GemmJob j1) {
  LAS unsigned char* lds = (LAS unsigned char*)smem;
  const int tid = tid_l(), wid = __builtin_amdgcn_readfirstlane(tid >> 6), lane = tid & 63, wr = wid >> 2, wc = wid & 3, fr = lane & 15, fq = lane >> 4;
  const int K = j0.K, nt = K / BK;
  constexpr int HTB = HALF * BK * 2;
  unsigned voff[2];
#pragma unroll
  for (int i = 0; i < 2; ++i) { int R, C; stage_rc(tid * 16 + i * 8192, R, C); voff[i] = (unsigned)(R * K + C) * 2u; }
  const size_t kstep = (size_t)(BK * 2), hstep = (size_t)HALF * K * 2, tstep = 2 * hstep;
  const unsigned ldsw = (unsigned)wid * 1024u;
  const int aoff = lds_byte(wr * 64 + fr, fq * 8), boff = lds_byte(wc * 32 + fr, fq * 8);
#define G_SA(b, h) (((b) * 2 + (h)) * HTB)
#define G_SB(b, h) ((4 + (b) * 2 + (h)) * HTB)
#define G_STAGE(bufoff, gbase) do { _Pragma("unroll") for (int _i = 0; _i < 2; ++_i) \
    __builtin_amdgcn_global_load_lds((const unsigned*)((const char*)(gbase) + voff[_i]), (LAS unsigned*)(lds + (bufoff) + ldsw + _i * 8192), 16, 0, 0); } while (0)
#define G_LDA(dst, b, h) do { _Pragma("unroll") for (int m = 0; m < 4; ++m) _Pragma("unroll") for (int k = 0; k < 2; ++k) dst[m][k] = *(const LAS bf16x8*)(lds + G_SA(b, h) + aoff + m * 2048 + k * 1024); } while (0)
#define G_LDB(dst, b, h) do { _Pragma("unroll") for (int n = 0; n < 2; ++n) _Pragma("unroll") for (int k = 0; k < 2; ++k) dst[n][k] = *(const LAS bf16x8*)(lds + G_SB(b, h) + boff + n * 2048 + k * 1024); } while (0)
#define G_MMA(ai, bj, At_, Bt_) do { __builtin_amdgcn_s_setprio(1); _Pragma("unroll") for (int m = 0; m < 4; ++m) _Pragma("unroll") for (int n = 0; n < 2; ++n) _Pragma("unroll") for (int k = 0; k < 2; ++k) \
    acc[ai][bj][m][n] = __builtin_amdgcn_mfma_f32_16x16x32_bf16(Bt_[n][k], At_[m][k], acc[ai][bj][m][n], 0, 0, 0); __builtin_amdgcn_s_setprio(0); } while (0)
#define G_WAIT_V(n) asm volatile("s_waitcnt vmcnt(" #n ")" ::: "memory")
#define G_WAIT_L(n) asm volatile("s_waitcnt lgkmcnt(" #n ")" ::: "memory")
#define G_BAR __builtin_amdgcn_s_barrier()
#define G_SCHED __builtin_amdgcn_sched_barrier(0)
  Unit cur, nxt; int ui = 0;
  if (!next_unit(j0, j1, 0, cur)) return;
  f32x4 acc[2][2][4][2];
#pragma unroll
  for (int a = 0; a < 2; ++a)
#pragma unroll
    for (int b = 0; b < 2; ++b)
#pragma unroll
      for (int m = 0; m < 4; ++m)
#pragma unroll
        for (int n = 0; n < 2; ++n) acc[a][b][m][n] = (f32x4){0.f, 0.f, 0.f, 0.f};
  bf16x8 At[4][2], B0[2][2], B1[2][2];
  float rsraw[8];
#pragma unroll
  for (int r_ = 0; r_ < 8; ++r_) rsraw[r_] = 0.f;
  const char* cA = cur.A + (size_t)cur.pm * tstep; const char* cB = cur.B + (size_t)cur.pn * tstep;
  G_STAGE(G_SB(0, 0), cB); G_STAGE(G_SA(0, 0), cA); G_STAGE(G_SB(0, 1), cB + hstep); G_STAGE(G_SA(0, 1), cA + hstep);
  if (wr == 1) G_BAR;
  G_WAIT_V(4); G_BAR;
  G_STAGE(G_SB(1, 0), cB + kstep); G_STAGE(G_SA(1, 0), cA + kstep); G_STAGE(G_SB(1, 1), cB + hstep + kstep);
  G_WAIT_V(6); G_BAR;
  for (;;) {
    const bool has_next = next_unit(j0, j1, ui + 1, nxt);
    const char* nA = has_next ? nxt.A + (size_t)nxt.pm * tstep : cA; const char* nB = has_next ? nxt.B + (size_t)nxt.pn * tstep : cB;
    for (int t = 0; t < nt; t += 2) {
      const bool last = (t == nt - 2);
      if (last) {
        GCHAR* wsl = (GCHAR*)P.ws; asm volatile("" : "+s"(wsl));
        size_t so;
        switch (cur.mode) {
          case M_SWIGLU: so = cur.aux ? OFF_ssq3 : OFF_ssq1; break;
          case M_WIN: so = OFF_ssq2; break;
          case M_QUP: so = OFF_ssq_q; break;
          case M_KVUP: so = OFF_ssq_kv; break;
          case M_PLE: so = OFF_ssq4; break;
          default: so = OFF_ssq1; break;
        }
        const float* sp = (const float*)(wsl + so) + cur.pm * BM + wr * 64 + fr;
#pragma unroll
        for (int r_ = 0; r_ < 8; ++r_) rsraw[r_] = sp[(r_ >> 2) * 128 + (r_ & 3) * 16];
      }
      const char* a1 = cA + (size_t)(t + 1) * kstep;
      const char* a2 = last ? nA : cA + (size_t)(t + 2) * kstep; const char* b2 = last ? nB : cB + (size_t)(t + 2) * kstep;
      const char* a3 = a2 + kstep; const char* b3 = b2 + kstep;
      G_LDB(B0, 0, 0); G_SCHED; G_LDA(At, 0, 0); G_STAGE(G_SA(1, 1), a1 + hstep);
      G_WAIT_L(8); G_BAR; G_WAIT_L(0); G_MMA(0, 0, At, B0); G_BAR; G_SCHED;
      G_LDB(B1, 0, 1); G_STAGE(G_SB(0, 0), b2);
      G_BAR; G_WAIT_L(0); G_MMA(0, 1, At, B1); G_BAR;
      G_LDA(At, 0, 1); G_STAGE(G_SA(0, 0), a2);
      G_BAR; G_WAIT_L(0); G_MMA(1, 0, At, B0); G_BAR; G_SCHED;
      G_STAGE(G_SB(0, 1), b2 + hstep);
      G_WAIT_V(6); G_BAR; G_MMA(1, 1, At, B1); G_BAR;
      G_LDB(B0, 1, 0); G_SCHED; G_LDA(At, 1, 0); G_STAGE(G_SA(0, 1), a2 + hstep);
      G_WAIT_L(8); G_BAR; G_WAIT_L(0); G_MMA(0, 0, At, B0); G_BAR; G_SCHED;
      G_LDB(B1, 1, 1); G_STAGE(G_SB(1, 0), b3);
      G_BAR; G_WAIT_L(0); G_MMA(0, 1, At, B1); G_BAR;
      G_LDA(At, 1, 1); G_STAGE(G_SA(1, 0), a3);
      G_BAR; G_WAIT_L(0); G_MMA(1, 0, At, B0); G_BAR; G_SCHED;
      G_STAGE(G_SB(1, 1), b3 + hstep);
      G_WAIT_V(6); G_BAR; G_MMA(1, 1, At, B1); G_BAR;
    }
    run_epilogue(P, acc, cur, rsraw);
    if (!has_next) break;
#pragma unroll
    for (int a = 0; a < 2; ++a)
#pragma unroll
      for (int b = 0; b < 2; ++b)
#pragma unroll
        for (int m = 0; m < 4; ++m)
#pragma unroll
          for (int n = 0; n < 2; ++n) acc[a][b][m][n] = (f32x4){0.f, 0.f, 0.f, 0.f};
    cur = nxt; cA = nA; cB = nB; ++ui;
  }
  G_WAIT_V(0);
  if (wr == 0) G_BAR;
  G_BAR;
#undef G_SA
#undef G_SB
#undef G_STAGE
#undef G_LDA
#undef G_LDB
#undef G_MMA
}


#define LDS_BARRIER() do { asm volatile("s_waitcnt lgkmcnt(0)" ::: "memory"); __builtin_amdgcn_s_barrier(); asm volatile("" ::: "memory"); } while (0)

constexpr int HG_QT = 0, HG_KT = 17408, HG_KTT = 34816, HG_VT = 53248, HG_PART = 71680, HG_EL = 73728, HG_P = 74240;

constexpr int PP_BL = 0, PP_QR = 32768, PP_QT = 50176, PP_KT = 67584, PP_KTT = 84992;
__device__ __forceinline__ void hgrn_prepass(const Params& P) {
  GCHAR* ws_ = (GCHAR*)P.ws; asm volatile("" : "+s"(ws_));
  const int tid = tid_l(), d = tid & 127, seg = tid >> 7;
  float* bL = (float*)(smem + PP_BL);
  f32x4 lg[4]; u32x4 qq[2];
  const bool bal = (gridDim.x == 256);
  const int nit = bal ? (blockIdx.x < 128 ? 6 : 10) : (2048 - (int)blockIdx.x + (int)gridDim.x - 1) / (int)gridDim.x;
#define PP_ITEM(k_) (bal ? ((k_) < 6 ? (k_) * 256 + (int)blockIdx.x : 1536 + ((k_) - 6) * 128 + ((int)blockIdx.x - 128)) : (k_) * (int)gridDim.x + (int)blockIdx.x)
#define PP_LOAD(item_) do { const int bh_ = (item_) >> 5, c_ = (item_) & 31, b_ = bh_ >> 2, h_ = bh_ & 3; const size_t t0_ = (size_t)b_ * SEQ + c_ * 64; \
    _Pragma("unroll") for (int r = 0; r < 4; ++r) lg[r] = *(const f32x4*)(((const float*)(ws_ + OFF_logf)) + (t0_ + (tid >> 5) + r * 16) * 512 + h_ * 128 + (tid & 31) * 4); \
    _Pragma("unroll") for (int r = 0; r < 2; ++r) qq[r] = *(const u32x4*)(((const bf16_t*)(ws_ + OFF_qh)) + (t0_ + (tid >> 4) + r * 32) * 512 + h_ * 128 + (tid & 15) * 8); } while (0)
  if (nit > 0) PP_LOAD(PP_ITEM(0));
  __syncthreads();
  for (int k = 0; k < nit; ++k) {
    const int it = PP_ITEM(k);
    const int bh = it >> 5, c = it & 31, b = bh >> 2, h = bh & 3;
    const size_t t0 = (size_t)b * SEQ + c * 64;
#pragma unroll
    for (int r = 0; r < 4; ++r) *(f32x4*)(bL + ((tid >> 5) + r * 16) * 128 + (tid & 31) * 4) = lg[r];
#pragma unroll
    for (int r = 0; r < 2; ++r) *(u32x4*)(smem + PP_QR + ((tid >> 4) + r * 32) * 272 + (tid & 15) * 16) = qq[r];
    if (k + 1 < nit) PP_LOAD(PP_ITEM(k + 1));
    LDS_BARRIER();
    {
      float p = 1.f;
#pragma unroll
      for (int sgm = 0; sgm < 3; ++sgm)
        if (sgm < seg) {
#pragma unroll
          for (int i = 0; i < 16; ++i) p *= bL[(sgm * 16 + i) * 128 + d];
        }
      unsigned kt_pk[8];
      float kprev = 0.f;
#pragma unroll
      for (int i = 0; i < 16; ++i) {
        const int t = seg * 16 + i;
        const float f = bL[t * 128 + d];
        p *= f;
        const float q = bf2f(*(const bf16_t*)(smem + PP_QR + t * 272 + d * 2));
        const float qt = q * p, kt = (1.f - f) * __builtin_amdgcn_rcpf(p);
        const unsigned qk = cvt_pk(qt, kt);
        *(bf16_t*)(smem + PP_QT + t * 272 + d * 2) = (bf16_t)(qk & 0xffffu);
        *(bf16_t*)(smem + PP_KT + t * 272 + d * 2) = (bf16_t)(qk >> 16);
        if (i & 1) kt_pk[i >> 1] = cvt_pk(kprev, kt); else kprev = kt;
      }
      if (seg == 3) ((float*)(ws_ + OFF_elast))[(size_t)it * 128 + d] = p;
      *(u32x4*)(smem + PP_KTT + d * 128 + seg * 32) = (u32x4){kt_pk[0], kt_pk[1], kt_pk[2], kt_pk[3]};
      *(u32x4*)(smem + PP_KTT + d * 128 + seg * 32 + 16) = (u32x4){kt_pk[4], kt_pk[5], kt_pk[6], kt_pk[7]};
    }
    LDS_BARRIER();
#pragma unroll
    for (int r = 0; r < 2; ++r) {
      const int row = (tid >> 4) + r * 32, ch = tid & 15;
      *(u32x4*)(((bf16_t*)(ws_ + OFF_qh)) + (t0 + row) * 512 + h * 128 + ch * 8) = *(const u32x4*)(smem + PP_QT + row * 272 + ch * 16);
      *(u32x4*)((bf16_t*)(((float*)(ws_ + OFF_logf)) + (t0 + row) * 512 + h * 128) + ch * 8) = *(const u32x4*)(smem + PP_KT + row * 272 + ch * 16);
      *(u32x4*)(((bf16_t*)(ws_ + OFF_ktt)) + (size_t)it * 8192 + (tid + r * 512) * 8) = *(const u32x4*)(smem + PP_KTT + (tid + r * 512) * 16);
    }
  }
#undef PP_ITEM
#undef PP_LOAD
  __syncthreads();
}

__device__ __forceinline__ void hgrn_item(const Params& P, const int bh) {
  GCHAR* ws_ = (GCHAR*)P.ws; asm volatile("" : "+s"(ws_));
  const int b = bh >> 2, h = bh & 3;
  const int tid = tid_l(), wid = tid >> 6, lane = tid & 63, fr = lane & 15, fq = lane >> 4;
  float* part = (float*)(smem + HG_PART);
  float* elast = (float*)(smem + HG_EL);
  f32x4 S[8];
#pragma unroll
  for (int i = 0; i < 8; ++i) S[i] = (f32x4){0.f, 0.f, 0.f, 0.f};
  const f32x4 gain4 = *(const f32x4*)(P.hg_norm + h * 128 + wid * 16 + fq * 4);
  const bf16_t* qp = ((bf16_t*)(ws_ + OFF_qh)) + (size_t)(b * SEQ + (tid >> 4)) * 512 + h * 128 + (tid & 15) * 8;
  const bf16_t* kp_ = (const bf16_t*)(((float*)(ws_ + OFF_logf)) + (size_t)(b * SEQ + (tid >> 4)) * 512 + h * 128) + (tid & 15) * 8;
  const bf16_t* ktp = ((bf16_t*)(ws_ + OFF_ktt)) + (size_t)bh * 32 * 8192 + tid * 8;
  const bf16_t* vp = ((bf16_t*)(ws_ + OFF_vhT)) + (size_t)(h * 128 + (tid >> 3)) * T + b * SEQ + (tid & 7) * 8;
  const float* elp = ((float*)(ws_ + OFF_elast)) + (size_t)bh * 32 * 128 + (tid & 127);
  const bf16_t* sgp = ((bf16_t*)(ws_ + OFF_sg)) + (size_t)(b * SEQ + fr) * 512 + h * 128 + wid * 16 + fq * 4;
  u32x4 qq[2], kk[2], kt2[2], vv[2]; float elv;
#pragma unroll
  for (int r = 0; r < 2; ++r) {
    qq[r] = *(const u32x4*)(qp + (size_t)r * 32 * 512); kk[r] = *(const u32x4*)(kp_ + (size_t)r * 32 * 1024);
    kt2[r] = *(const u32x4*)(ktp + r * 4096); vv[r] = *(const u32x4*)(vp + (size_t)r * 64 * T);
  }
  elv = *elp;
  __syncthreads();
  for (int c = 0; c < 32; ++c) {
    const int t0 = b * SEQ + c * 64;
#pragma unroll
    for (int r = 0; r < 2; ++r) {
      *(u32x4*)(smem + HG_QT + ((tid >> 4) + r * 32) * 272 + (tid & 15) * 16) = qq[r];
      *(u32x4*)(smem + HG_KT + ((tid >> 4) + r * 32) * 272 + (tid & 15) * 16) = kk[r];
      *(u32x4*)(smem + HG_KTT + ((tid >> 3) + r * 64) * 144 + (tid & 7) * 16) = kt2[r];
      *(u32x4*)(smem + HG_VT + ((tid >> 3) + r * 64) * 144 + (tid & 7) * 16) = vv[r];
    }
    if (tid < 128) elast[tid] = elv;
    u32x2 sgv[4];
#pragma unroll
    for (int tt = 0; tt < 4; ++tt) sgv[tt] = *(const u32x2*)(sgp + (size_t)(c * 64 + tt * 16) * 512);
    if (c + 1 < 32) {
#pragma unroll
      for (int r = 0; r < 2; ++r) {
        qq[r] = *(const u32x4*)(qp + (size_t)((c + 1) * 64 + r * 32) * 512); kk[r] = *(const u32x4*)(kp_ + (size_t)((c + 1) * 64 + r * 32) * 1024);
        kt2[r] = *(const u32x4*)(ktp + (size_t)(c + 1) * 8192 + r * 4096); vv[r] = *(const u32x4*)(vp + (size_t)r * 64 * T + (c + 1) * 64);
      }
      elv = elp[(c + 1) * 128];
    }
    LDS_BARRIER();
    bf16x8 Sf[4];
#pragma unroll
    for (int ks = 0; ks < 4; ++ks) {
      u32x4 u = {cvt_pk(S[2 * ks][0], S[2 * ks][1]), cvt_pk(S[2 * ks][2], S[2 * ks][3]), cvt_pk(S[2 * ks + 1][0], S[2 * ks + 1][1]), cvt_pk(S[2 * ks + 1][2], S[2 * ks + 1][3])};
      Sf[ks] = __builtin_bit_cast(bf16x8, u);
    }
    f32x4 o[4];
    {
      const int wu = __builtin_amdgcn_readfirstlane(wid);
      for (int pi = wu; pi < 10; pi += 8) {
        const int tt = (pi >= 6) ? 3 : (pi >= 3) ? 2 : (pi >= 1) ? 1 : 0, st = pi - ((tt * (tt + 1)) >> 1);
        bf16x8 kf4[4], qf4[4];
#pragma unroll
        for (int ks = 0; ks < 4; ++ks) {
          kf4[ks] = *(const bf16x8*)(smem + HG_KT + (st * 16 + fr) * 272 + (ks * 32 + fq * 8) * 2);
          qf4[ks] = *(const bf16x8*)(smem + HG_QT + (tt * 16 + fr) * 272 + (ks * 32 + fq * 8) * 2);
        }
        f32x4 sc = (f32x4){0.f, 0.f, 0.f, 0.f};
#pragma unroll
        for (int ks = 0; ks < 4; ++ks) sc = __builtin_amdgcn_mfma_f32_16x16x32_bf16(kf4[ks], qf4[ks], sc, 0, 0, 0);
        if (st == tt) {
#pragma unroll
          for (int j = 0; j < 4; ++j) if (fq * 4 + j > fr) sc[j] = 0.f;
        }
        char* dstp = smem + HG_P + (tt * 2 + (st >> 1)) * 1024 + lane * 16 + (st & 1) * 8;
        *(u32x2*)dstp = (u32x2){cvt_pk(sc[0], sc[1]), cvt_pk(sc[2], sc[3])};
        if (!(st & 1) && st + 1 > tt) *(u32x2*)(dstp + 8) = (u32x2){0u, 0u};
      }
      bf16x8 vuA[2], quA[4][4];
#pragma unroll
      for (int kp = 0; kp < 2; ++kp) {
        const u32x2 v0 = *(const u32x2*)(smem + HG_VT + (wid * 16 + fr) * 144 + ((2 * kp) * 16 + fq * 4) * 2);
        const u32x2 v1 = *(const u32x2*)(smem + HG_VT + (wid * 16 + fr) * 144 + ((2 * kp + 1) * 16 + fq * 4) * 2);
        u32x4 vu = {v0[0], v0[1], v1[0], v1[1]};
        vuA[kp] = __builtin_bit_cast(bf16x8, vu);
      }
#pragma unroll
      for (int tt = 0; tt < 4; ++tt)
#pragma unroll
        for (int ks = 0; ks < 4; ++ks) {
          const u32x2 q0 = *(const u32x2*)(smem + HG_QT + (tt * 16 + fr) * 272 + ((2 * ks) * 16 + fq * 4) * 2);
          const u32x2 q1 = *(const u32x2*)(smem + HG_QT + (tt * 16 + fr) * 272 + ((2 * ks + 1) * 16 + fq * 4) * 2);
          u32x4 qu = {q0[0], q0[1], q1[0], q1[1]};
          quA[tt][ks] = __builtin_bit_cast(bf16x8, qu);
        }
#pragma unroll
      for (int tt = 0; tt < 4; ++tt) o[tt] = (f32x4){0.f, 0.f, 0.f, 0.f};
#pragma unroll
      for (int ks = 0; ks < 4; ++ks)
#pragma unroll
        for (int tt = 0; tt < 4; ++tt) o[tt] = __builtin_amdgcn_mfma_f32_16x16x32_bf16(Sf[ks], quA[tt][ks], o[tt], 0, 0, 0);
      LDS_BARRIER();
      bf16x8 pf[6];
      pf[0] = *(const bf16x8*)(smem + HG_P + 0 * 1024 + lane * 16);
      pf[1] = *(const bf16x8*)(smem + HG_P + 2 * 1024 + lane * 16);
      pf[2] = *(const bf16x8*)(smem + HG_P + 4 * 1024 + lane * 16);
      pf[3] = *(const bf16x8*)(smem + HG_P + 5 * 1024 + lane * 16);
      pf[4] = *(const bf16x8*)(smem + HG_P + 6 * 1024 + lane * 16);
      pf[5] = *(const bf16x8*)(smem + HG_P + 7 * 1024 + lane * 16);
      o[0] = __builtin_amdgcn_mfma_f32_16x16x32_bf16(vuA[0], pf[0], o[0], 0, 0, 0);
      o[1] = __builtin_amdgcn_mfma_f32_16x16x32_bf16(vuA[0], pf[1], o[1], 0, 0, 0);
      o[2] = __builtin_amdgcn_mfma_f32_16x16x32_bf16(vuA[0], pf[2], o[2], 0, 0, 0);
      o[3] = __builtin_amdgcn_mfma_f32_16x16x32_bf16(vuA[0], pf[4], o[3], 0, 0, 0);
      o[2] = __builtin_amdgcn_mfma_f32_16x16x32_bf16(vuA[1], pf[3], o[2], 0, 0, 0);
      o[3] = __builtin_amdgcn_mfma_f32_16x16x32_bf16(vuA[1], pf[5], o[3], 0, 0, 0);
      float sq[4];
#pragma unroll
      for (int tt = 0; tt < 4; ++tt) sq[tt] = o[tt][0] * o[tt][0] + o[tt][1] * o[tt][1] + o[tt][2] * o[tt][2] + o[tt][3] * o[tt][3];
#pragma unroll
      for (int tt = 0; tt < 4; ++tt) sq[tt] += __shfl_xor(sq[tt], 16);
#pragma unroll
      for (int tt = 0; tt < 4; ++tt) sq[tt] += __shfl_xor(sq[tt], 32);
      if (fq == 0) {
#pragma unroll
        for (int tt = 0; tt < 4; ++tt) part[wid * 64 + tt * 16 + fr] = sq[tt];
      }
    }
    {
      bf16x8 vf[2], kfS[8][2];
      f32x4 el[8];
#pragma unroll
      for (int ks = 0; ks < 2; ++ks) vf[ks] = *(const bf16x8*)(smem + HG_VT + (wid * 16 + fr) * 144 + (ks * 32 + fq * 8) * 2);
#pragma unroll
      for (int mt = 0; mt < 8; ++mt) {
#pragma unroll
        for (int ks = 0; ks < 2; ++ks) kfS[mt][ks] = *(const bf16x8*)(smem + HG_KTT + (mt * 16 + fr) * 144 + (ks * 32 + fq * 8) * 2);
        el[mt] = *(const f32x4*)(elast + mt * 16 + fq * 4);
      }
#pragma unroll
      for (int ks = 0; ks < 2; ++ks)
#pragma unroll
        for (int mt = 0; mt < 8; ++mt) S[mt] = __builtin_amdgcn_mfma_f32_16x16x32_bf16(kfS[mt][ks], vf[ks], S[mt], 0, 0, 0);
#pragma unroll
      for (int mt = 0; mt < 8; ++mt) S[mt] *= el[mt];
    }
    LDS_BARRIER();
    float pt[4][8];
#pragma unroll
    for (int tt = 0; tt < 4; ++tt)
#pragma unroll
      for (int w = 0; w < 8; ++w) pt[tt][w] = part[w * 64 + tt * 16 + fr];
#pragma unroll
    for (int tt = 0; tt < 4; ++tt) {
      const int t = tt * 16 + fr;
      float tot = 0.f;
#pragma unroll
      for (int w = 0; w < 8; ++w) tot += pt[tt][w];
      const float rs = rsqrtf(tot * (1.f / 128.f) + 1e-6f);
      const u32x2 gv = sgv[tt];
      f32x4 r;
      r[0] = o[tt][0] * rs * gain4[0] * __uint_as_float(gv[0] << 16);
      r[1] = o[tt][1] * rs * gain4[1] * __uint_as_float(gv[0] & 0xffff0000u);
      r[2] = o[tt][2] * rs * gain4[2] * __uint_as_float(gv[1] << 16);
      r[3] = o[tt][3] * rs * gain4[3] * __uint_as_float(gv[1] & 0xffff0000u);
      store_bf4(((bf16_t*)(ws_ + OFF_cc)) + (size_t)(t0 + t) * DM + h * 128 + wid * 16 + fq * 4, r);
    }
  }
  __syncthreads();
}

constexpr int AT_KSTRIDE = 400, AT_VSTRIDE = 144, AT_KBYTES = 64 * AT_KSTRIDE, AT_VBYTES = 128 * AT_VSTRIDE, AT_BUF = AT_KBYTES + AT_VBYTES;

__device__ __forceinline__ void attn_qblock(const Params& P, const int b, const int h, const int jq) {
  GCHAR* ws_ = (GCHAR*)P.ws; asm volatile("" : "+s"(ws_));
  const int tid = tid_l(), wid = tid >> 6, lane = tid & 63, fr = lane & 15, fq = lane >> 4;
  const int qpos0 = jq * 256 + wid * 32;
  const size_t tok0 = (size_t)b * SEQ;
  bf16x8 Qf[2][6];
#pragma unroll
  for (int qt = 0; qt < 2; ++qt)
#pragma unroll
    for (int ks = 0; ks < 6; ++ks)
      Qf[qt][ks] = *(const bf16x8*)(((bf16_t*)P.out) + (tok0 + qpos0 + qt * 16 + fr) * 768 + h * 192 + ks * 32 + fq * 8);
  f32x4 O[8][2];
#pragma unroll
  for (int i = 0; i < 8; ++i) { O[i][0] = (f32x4){0.f, 0.f, 0.f, 0.f}; O[i][1] = (f32x4){0.f, 0.f, 0.f, 0.f}; }
  float mrun[2] = {-INFINITY, -INFINITY}, lrun[2] = {0.f, 0.f};
  const int nkt = (jq + 1) * 4;
  int kkey[3], kch[3];
#pragma unroll
  for (int r = 0; r < 3; ++r) { const int i = tid + r * 512; kkey[r] = i / 24; kch[r] = i % 24; }
  const bf16_t* Kbase = ((bf16_t*)(ws_ + OFF_Kb)) + tok0 * 768 + h * 192;
  const bf16_t* Vbase = ((bf16_t*)(ws_ + OFF_Vt)) + (size_t)(b * 4 + h) * 128 * SEQ;
  u32x4 kreg[3], vreg[2];
#define AT_LOAD(kt_) do { \
    _Pragma("unroll") for (int r = 0; r < 3; ++r) kreg[r] = *(const u32x4*)(Kbase + (size_t)((kt_) * 64 + kkey[r]) * 768 + kch[r] * 8); \
    _Pragma("unroll") for (int r = 0; r < 2; ++r) { const int i = tid + r * 512; vreg[r] = *(const u32x4*)(Vbase + (size_t)(i >> 3) * SEQ + (kt_) * 64 + (i & 7) * 8); } } while (0)
#define AT_WRITE(buf_) do { char* bp = smem + (buf_) * AT_BUF; \
    _Pragma("unroll") for (int r = 0; r < 3; ++r) *(u32x4*)(bp + kkey[r] * AT_KSTRIDE + kch[r] * 16) = kreg[r]; \
    _Pragma("unroll") for (int r = 0; r < 2; ++r) { const int i = tid + r * 512; *(u32x4*)(bp + AT_KBYTES + (i >> 3) * AT_VSTRIDE + (i & 7) * 16) = vreg[r]; } } while (0)
  __syncthreads();
  AT_LOAD(0); AT_WRITE(0);
  __syncthreads();
  for (int kt = 0; kt < nkt; ++kt) {
    if (kt + 1 < nkt) AT_LOAD(kt + 1);
    const int kpos0 = kt * 64;
    if (kpos0 <= qpos0 + 31) {
      const char* kb = smem + (kt & 1) * AT_BUF;
      const char* vb = kb + AT_KBYTES;
      f32x4 s[4][2];
#pragma unroll
      for (int i = 0; i < 4; ++i) { s[i][0] = (f32x4){0.f, 0.f, 0.f, 0.f}; s[i][1] = (f32x4){0.f, 0.f, 0.f, 0.f}; }
      {
        bf16x8 kfa[2], kfb[2];
#define AT_LDK(dst, g_) _Pragma("unroll") for (int e = 0; e < 2; ++e) dst[e] = *(const bf16x8*)(kb + ((((g_) & 1) * 2 + e) * 16 + fr) * AT_KSTRIDE + (((g_) >> 1) * 32 + fq * 8) * 2)
#define AT_QK(src, g_) _Pragma("unroll") for (int e = 0; e < 2; ++e) { const int k4_ = ((g_) & 1) * 2 + e, ks_ = (g_) >> 1; \
          s[k4_][0] = __builtin_amdgcn_mfma_f32_16x16x32_bf16(src[e], Qf[0][ks_], s[k4_][0], 0, 0, 0); \
          s[k4_][1] = __builtin_amdgcn_mfma_f32_16x16x32_bf16(src[e], Qf[1][ks_], s[k4_][1], 0, 0, 0); }
        AT_LDK(kfa, 0);
#pragma unroll
        for (int g = 0; g < 12; g += 2) {
          AT_LDK(kfb, g + 1);
          __builtin_amdgcn_sched_barrier(0);
          __builtin_amdgcn_s_setprio(1);
          AT_QK(kfa, g);
          __builtin_amdgcn_s_setprio(0);
          __builtin_amdgcn_sched_barrier(0);
          if (g + 2 < 12) { AT_LDK(kfa, g + 2); }
          __builtin_amdgcn_sched_barrier(0);
          __builtin_amdgcn_s_setprio(1);
          AT_QK(kfb, g + 1);
          __builtin_amdgcn_s_setprio(0);
          __builtin_amdgcn_sched_barrier(0);
        }
#undef AT_LDK
#undef AT_QK
      }
      __builtin_amdgcn_s_setprio(0);
      if (kpos0 + 63 > qpos0) {
#pragma unroll
        for (int k4 = 0; k4 < 4; ++k4)
#pragma unroll
          for (int qt = 0; qt < 2; ++qt)
#pragma unroll
            for (int j = 0; j < 4; ++j)
              if (kpos0 + k4 * 16 + fq * 4 + j > qpos0 + qt * 16 + fr) s[k4][qt][j] = -INFINITY;
      }
      bf16x8 Pf[2][2];
#pragma unroll
      for (int qt = 0; qt < 2; ++qt) {
        float mx = -INFINITY;
#pragma unroll
        for (int k4 = 0; k4 < 4; ++k4)
#pragma unroll
          for (int j = 0; j < 4; ++j) mx = fmaxf(mx, s[k4][qt][j]);
        mx = fmaxf(mx, __shfl_xor(mx, 16)); mx = fmaxf(mx, __shfl_xor(mx, 32));
        const float mnew = fmaxf(mrun[qt], mx);
        const float alpha = __builtin_amdgcn_exp2f(mrun[qt] - mnew);
        mrun[qt] = mnew;
        float ps = 0.f;
#pragma unroll
        for (int k4 = 0; k4 < 4; ++k4)
#pragma unroll
          for (int j = 0; j < 4; ++j) { const float pv = __builtin_amdgcn_exp2f(s[k4][qt][j] - mnew); s[k4][qt][j] = pv; ps += pv; }
        lrun[qt] = lrun[qt] * alpha + ps;
#pragma unroll
        for (int dvt = 0; dvt < 8; ++dvt) O[dvt][qt] *= alpha;
#pragma unroll
        for (int kp = 0; kp < 2; ++kp) {
          u32x4 pu = {cvt_pk(s[2 * kp][qt][0], s[2 * kp][qt][1]), cvt_pk(s[2 * kp][qt][2], s[2 * kp][qt][3]),
                      cvt_pk(s[2 * kp + 1][qt][0], s[2 * kp + 1][qt][1]), cvt_pk(s[2 * kp + 1][qt][2], s[2 * kp + 1][qt][3])};
          Pf[qt][kp] = __builtin_bit_cast(bf16x8, pu);
        }
      }
      {
        bf16x8 va[2], vbq[2];
#define AT_LDV(dst, g_) _Pragma("unroll") for (int e = 0; e < 2; ++e) { const int dvt_ = (g_), kp_ = e; \
          const u32x2 v0 = *(const u32x2*)(vb + (dvt_ * 16 + fr) * AT_VSTRIDE + ((2 * kp_) * 16 + fq * 4) * 2); \
          const u32x2 v1 = *(const u32x2*)(vb + (dvt_ * 16 + fr) * AT_VSTRIDE + ((2 * kp_ + 1) * 16 + fq * 4) * 2); \
          u32x4 vu = {v0[0], v0[1], v1[0], v1[1]}; dst[e] = __builtin_bit_cast(bf16x8, vu); }
#define AT_PV(src, g_) _Pragma("unroll") for (int e = 0; e < 2; ++e) { const int dvt_ = (g_), kp_ = e; \
          O[dvt_][0] = __builtin_amdgcn_mfma_f32_16x16x32_bf16(src[e], Pf[0][kp_], O[dvt_][0], 0, 0, 0); \
          O[dvt_][1] = __builtin_amdgcn_mfma_f32_16x16x32_bf16(src[e], Pf[1][kp_], O[dvt_][1], 0, 0, 0); }
        AT_LDV(va, 0);
#pragma unroll
        for (int g = 0; g < 8; g += 2) {
          AT_LDV(vbq, g + 1);
          __builtin_amdgcn_sched_barrier(0);
          __builtin_amdgcn_s_setprio(1);
          AT_PV(va, g);
          __builtin_amdgcn_s_setprio(0);
          __builtin_amdgcn_sched_barrier(0);
          if (g + 2 < 8) { AT_LDV(va, g + 2); }
          __builtin_amdgcn_sched_barrier(0);
          __builtin_amdgcn_s_setprio(1);
          AT_PV(vbq, g + 1);
          __builtin_amdgcn_s_setprio(0);
          __builtin_amdgcn_sched_barrier(0);
        }
#undef AT_LDV
#undef AT_PV
      }
    }
    __builtin_amdgcn_s_setprio(0);
    if (kt + 1 < nkt) AT_WRITE((kt + 1) & 1);
    __syncthreads();
  }
#pragma unroll
  for (int qt = 0; qt < 2; ++qt) {
    float l = lrun[qt];
    l += __shfl_xor(l, 16); l += __shfl_xor(l, 32);
    const float inv = 1.f / l;
    bf16_t* dst = ((bf16_t*)(ws_ + OFF_cc)) + (tok0 + qpos0 + qt * 16 + fr) * DM + 512 + h * 128 + fq * 4;
#pragma unroll
    for (int dvt = 0; dvt < 8; ++dvt) store_bf4(dst + dvt * 16, O[dvt][qt] * inv);
  }
#undef AT_LOAD
#undef AT_WRITE
}


__device__ __forceinline__ void hgrn_dbg(const Params& P, const int bh) {
  GCHAR* ws_ = (GCHAR*)P.ws; asm volatile("" : "+s"(ws_));
  const int b = bh >> 2, h = bh & 3, tid = tid_l();
  for (int i = tid; i < SEQ * 128; i += 512) {
    const int t = b * SEQ + (i >> 7), d = i & 127;
    const float a = bf2f(((bf16_t*)(ws_ + OFF_sg))[(size_t)t * 512 + h * 128 + d]);
    const float q = bf2f(((bf16_t*)(ws_ + OFF_qh))[(size_t)t * 512 + h * 128 + d]);
    const float l = ((float*)(ws_ + OFF_logf))[(size_t)t * 512 + h * 128 + d];
    const float v = bf2f(((bf16_t*)(ws_ + OFF_vhT))[(size_t)(h * 128 + d) * T + t]);
    const unsigned o = cvt_pk(a * (q + l + v), 0.f);
    ((bf16_t*)(ws_ + OFF_cc))[(size_t)t * DM + h * 128 + d] = (bf16_t)(o & 0xffffu);
  }
}

__device__ __forceinline__ void phase_mix(const Params& P) {
  GCHAR* ws_ = (GCHAR*)P.ws; asm volatile("" : "+s"(ws_));
#ifndef DBG_SKIP_HGRN
  for (int it = blockIdx.x; it < 64; it += gridDim.x) hgrn_item(P, it);
#endif
  int* slot = (int*)(smem + LDS_STAGE + 16);
  const int tid = tid_l();
  for (;;) {
    __syncthreads();
    if (tid == 0) *slot = (int)atomicAdd((unsigned*)(ws_ + OFF_ctr), 1u);
    __syncthreads();
    const int it = *(volatile int*)slot;
    if (it >= 512) break;
    const int jq = 7 - (it >> 6), bh = it & 63;
    attn_qblock(P, bh >> 2, bh & 3, jq);
  }
}

__device__ __forceinline__ void phase_final(const Params& P) {
  GCHAR* ws_ = (GCHAR*)P.ws; asm volatile("" : "+s"(ws_));
  const int tid = tid_l(), lane = tid & 63, wid = tid >> 6;
  for (int row = blockIdx.x * 8 + wid; row < T; row += gridDim.x * 8) {
    const float rs = rsqrtf(((float*)(ws_ + OFF_ssq5))[row] * (1.f / 1024.f) + 1e-6f);
#pragma unroll
    for (int i = 0; i < 2; ++i) {
      const int col = i * 512 + lane * 8;
      const u32x4 hv = *(const u32x4*)(((const bf16_t*)(ws_ + OFF_cc)) + (size_t)row * DM + col);
      const f32x4 g0 = *(const f32x4*)(P.ln_final + col), g1 = *(const f32x4*)(P.ln_final + col + 4);
      f32x4 y0, y1;
      y0[0] = __uint_as_float(hv[0] << 16); y0[1] = __uint_as_float(hv[0] & 0xffff0000u); y0[2] = __uint_as_float(hv[1] << 16); y0[3] = __uint_as_float(hv[1] & 0xffff0000u);
      y1[0] = __uint_as_float(hv[2] << 16); y1[1] = __uint_as_float(hv[2] & 0xffff0000u); y1[2] = __uint_as_float(hv[3] << 16); y1[3] = __uint_as_float(hv[3] & 0xffff0000u);
      *(f32x4*)(P.out + (size_t)row * DM + col) = y0 * rs * g0;
      *(f32x4*)(P.out + (size_t)row * DM + col + 4) = y1 * rs * g1;
    }
  }
}


#define XB_TMO      128
#define XB_XCNT(j)  (256  + 64 * (j))
#define XB_XSUB(j)  (1280 + 64 * (j))
#define XB_XGEN(j)  (2304 + 64 * (j))
#define XB_TOP      3328
#define XB_TOPGEN   3392
#define XCD_BAR_WORDS 3456
#define XB_SPIN_CAP (1u << 18)
#define XLAS __attribute__((address_space(3)))
__device__ __forceinline__ unsigned xb_ld(unsigned* p)              { return __hip_atomic_load(p, __ATOMIC_RELAXED, __HIP_MEMORY_SCOPE_AGENT); }
__device__ __forceinline__ unsigned xb_add(unsigned* p, unsigned v) { return __hip_atomic_fetch_add(p, v, __ATOMIC_RELAXED, __HIP_MEMORY_SCOPE_AGENT); }
__device__ __forceinline__ unsigned xb_xcc_id() { return (unsigned)__builtin_amdgcn_s_getreg((3 << 11) | 20) & 0xFu; }
#define XB_SPIN(cond, bar) do { unsigned _sp = 0; while (cond) { __builtin_amdgcn_s_sleep(1); \
    if ((++_sp & 255u) == 0u) { if (xb_ld(&(bar)[XB_TMO])) break; if (_sp > XB_SPIN_CAP) { atomicAdd(&(bar)[XB_TMO], 1u); break; } } } } while (0)
struct XcdBarrier { unsigned* bar; unsigned x; volatile XLAS unsigned* st; };
__device__ __forceinline__ XcdBarrier xcd_barrier_post(unsigned* bar, volatile XLAS unsigned* st) {
  XcdBarrier b; b.bar = bar; b.x = xb_xcc_id(); b.st = st;
  if (threadIdx.x == 0) (void)xb_add(&bar[XB_XCNT(b.x)], 1u);
  return b;
}
__device__ __forceinline__ void xcd_barrier_complete(unsigned* bar, unsigned x, unsigned& nloc, unsigned& nx) {
  const unsigned G = gridDim.x * gridDim.y * gridDim.z;
  unsigned sum, cnt, mine, sp = 0u;
  for (;;) {
    sum = 0u; cnt = 0u; mine = 0u;
#pragma unroll
    for (unsigned j = 0; j < 16; ++j) { const unsigned c = xb_ld(&bar[XB_XCNT(j)]); sum += c; cnt += (c > 0u) ? 1u : 0u; mine = (j == x) ? c : mine; }
    if (sum == G) break;
    __builtin_amdgcn_s_sleep(1);
    if ((++sp & 255u) == 0u) { if (xb_ld(&bar[XB_TMO])) break; if (sp > XB_SPIN_CAP) { atomicAdd(&bar[XB_TMO], 1u); break; } }
  }
  nloc = mine > 0u ? mine : 1u; nx = cnt > 0u ? cnt : 1u;
}
__device__ __forceinline__ void xcd_barrier(const XcdBarrier& b) {
  asm volatile("s_waitcnt vmcnt(0)" ::: "memory");
  __syncthreads();
  if (threadIdx.x == 0) {
    unsigned* bar = b.bar;
    __builtin_amdgcn_s_waitcnt(0);
    unsigned nloc = b.st[0], nx = b.st[1];
    if (nloc == 0u) { xcd_barrier_complete(bar, b.x, nloc, nx); b.st[0] = nloc; b.st[1] = nx; }
    const unsigned old = xb_add(&bar[XB_XSUB(b.x)], 1u);
    const unsigned gen = old / nloc;
    if (old + 1u == (gen + 1u) * nloc) {
      __builtin_amdgcn_fence(__ATOMIC_RELEASE, "agent");
      asm volatile("s_waitcnt vmcnt(0)" ::: "memory");
      const unsigned og = xb_add(&bar[XB_TOP], 1u);
      const unsigned tg = og / nx;
      if (og + 1u == (tg + 1u) * nx) xb_add(&bar[XB_TOPGEN], 1u);
      else XB_SPIN(xb_ld(&bar[XB_TOPGEN]) == tg, bar);
      __builtin_amdgcn_fence(__ATOMIC_ACQUIRE, "agent");
      xb_add(&bar[XB_XGEN(b.x)], 1u);
      asm volatile("s_waitcnt vmcnt(0)" ::: "memory");
    } else {
      XB_SPIN(xb_ld(&bar[XB_XGEN(b.x)]) == gen, bar);
      __builtin_amdgcn_fence(__ATOMIC_ACQUIRE, "agent");
      asm volatile("s_waitcnt vmcnt(0)" ::: "memory");
    }
  }
  __syncthreads();
}

__global__ void __launch_bounds__(512) mega(const Params P) {
  cg::grid_group grid = cg::this_grid();
  volatile XLAS unsigned* xst = (volatile XLAS unsigned*)(smem + LDS_STAGE);
  if (threadIdx.x == 0) { xst[0] = 0u; xst[1] = 0u; }
  __syncthreads();
  const XcdBarrier xbar = xcd_barrier_post((unsigned*)(P.ws + OFF_bar), xst);
  const GemmJob none = mkjob(nullptr, nullptr, 0, 0, 0, 0);
  for (int step = P.ph_lo; step < P.ph_hi; ++step) {
    const int ph = (PROBE_REP >= 0 && step > PROBE_REP) ? step - 1 : step;
    if (step > P.ph_lo) { if (P.ph_hi > 1000) grid.sync(); else xcd_barrier(xbar); }
    GCHAR* ws_ = (GCHAR*)P.ws; asm volatile("" : "+s"(ws_));
    if (ph == 0) { phase0(P); continue; }
#ifdef DBG_SKIP_MIX
    if (ph == 5) continue;
#else
    if (ph == 5) { phase_mix(P); continue; }
#endif
    if (ph == 10) { phase_final(P); continue; }
    if (ph == 6) {
      gemm_phase(P, mkjob(((bf16_t*)(ws_ + OFF_cc)), ((bf16_t*)(ws_ + OFF_Woutt)), 1024, 4, M_RESID, 1), none);
      __syncthreads();
      gemm_phase(P, mkjob(((bf16_t*)(ws_ + OFF_pb)), ((bf16_t*)(ws_ + OFF_Wppt)), 256, 4, M_PP, 0), none);
      continue;
    }
    GemmJob j0 = none, j1 = none;
    switch (ph) {
      case 1: j0 = mkjob(((bf16_t*)(ws_ + OFF_hb)), ((bf16_t*)(ws_ + OFF_W1cat)), 1024, 22, M_SWIGLU, 0); break;
      case 2: j0 = mkjob(((bf16_t*)(ws_ + OFF_act)), ((bf16_t*)(ws_ + OFF_Wd1t)), 2816, 4, M_RESID, 0); break;
      case 3: j0 = mkjob(((bf16_t*)(ws_ + OFF_hb)), ((bf16_t*)(ws_ + OFF_Wint)), 1024, 10, M_WIN, 0); break;
      case 4: j0 = mkjob(((bf16_t*)(ws_ + OFF_cqb)), ((bf16_t*)(ws_ + OFF_Wqt)), 256, 3, M_QUP, 0); j1 = mkjob(((bf16_t*)(ws_ + OFF_ckvb)), ((bf16_t*)(ws_ + OFF_Wkvt)), 256, 4, M_KVUP, 0); break;
      case 7: j0 = mkjob(((bf16_t*)(ws_ + OFF_hb)), ((bf16_t*)(ws_ + OFF_W2cat)), 1024, 22, M_SWIGLU, 1); break;
      case 8: j0 = mkjob(((bf16_t*)(ws_ + OFF_act)), ((bf16_t*)(ws_ + OFF_Wd2t)), 2816, 4, M_RESID, 2); break;
      default: j0 = mkjob(((bf16_t*)(ws_ + OFF_hb)), ((bf16_t*)(ws_ + OFF_Wpgt)), 1024, 4, M_PLE, 0); break;
    }
    gemm_phase(P, j0, j1);
    if (ph == 4) {
      hgrn_prepass(P);
    }
  }
}

extern "C" void kernel_launch(void* const* d_in, const int* in_sizes, int n_in, void* d_out, int out_size, void* d_ws, size_t ws_size, hipStream_t stream) {
  static int grid_blocks = 0;
  if (!grid_blocks) {
    int dev = 0, cus = 0, per_cu = 0;
    hipGetDevice(&dev);
    hipDeviceGetAttribute(&cus, hipDeviceAttributeMultiprocessorCount, dev);
    hipFuncSetAttribute((const void*)mega, hipFuncAttributeMaxDynamicSharedMemorySize, LDS_BYTES);
    hipOccupancyMaxActiveBlocksPerMultiprocessor(&per_cu, (const void*)mega, 512, LDS_BYTES);
    if (per_cu < 1) { fprintf(stderr, "occupancy query returned %d\n", per_cu); per_cu = 1; }
    grid_blocks = cus * per_cu;
    if (grid_blocks > 256) grid_blocks = 256;
  }
  Params P{};
  const float* const* in = (const float* const*)d_in;
  P.x = in[0]; P.p = in[1]; P.pos = (const int*)d_in[2];
  P.ln_ffn1 = in[3]; P.w1g = in[4]; P.w1u = in[5]; P.w1d = in[6]; P.ln_mix = in[7]; P.w_in = in[8]; P.lb_logits = in[9]; P.hg_norm = in[10];
  P.q_a_norm = in[11]; P.w_q_up = in[12]; P.kv_a_norm = in[13]; P.w_kv_up = in[14]; P.w_out = in[15]; P.ln_ffn2 = in[16];
  P.w2g = in[17]; P.w2u = in[18]; P.w2d = in[19]; P.ln_ple = in[20]; P.w_pg = in[21]; P.w_pp = in[22]; P.ln_final = in[23];
  P.out = (float*)d_out;
  P.ws = (char*)d_ws;
  if ((size_t)WS_END > ws_size) { fprintf(stderr, "workspace too small: need %zu have %zu\n", (size_t)WS_END, ws_size); return; }
#ifndef N_LAUNCH
#define N_LAUNCH 1
#ifndef PROBE_REP
#define PROBE_REP -1
#endif
#endif
  (void)hipMemsetAsync((char*)d_ws + OFF_bar, 0, 16384, stream);
  for (int li = 0; li < N_LAUNCH; ++li) {
    P.ph_lo = (N_LAUNCH == 1) ? 0 : li; P.ph_hi = (N_LAUNCH == 1) ? 11 + (PROBE_REP >= 0 ? 1 : 0) : li + 1;
    void* args[] = {(void*)&P};
    hipError_t e = hipLaunchCooperativeKernel((const void*)mega, dim3(grid_blocks), dim3(512), args, LDS_BYTES, stream);
    if (e != hipSuccess) fprintf(stderr, "cooperative launch failed: %s (grid %d)\n", hipGetErrorString(e), grid_blocks);
  }
}
```

```cpp
#include <hip/hip_runtime.h>
#include <hip/hip_cooperative_groups.h>
#include <cstdio>
#define N_LAUNCH 1
#ifndef PROBE_REP
#define PROBE_REP -1
#endif


namespace cg = cooperative_groups;

typedef unsigned short bf16_t;
typedef short bf16x8 __attribute__((ext_vector_type(8)));
typedef float f32x4 __attribute__((ext_vector_type(4)));
typedef float f32x2 __attribute__((ext_vector_type(2)));
typedef unsigned u32x2 __attribute__((ext_vector_type(2)));
typedef unsigned u32x4 __attribute__((ext_vector_type(4)));

constexpr int T = 32768, DM = 1024, DFF = 2816, SEQ = 2048;
constexpr int BM = 256, BK = 64, HALF = 128, HT = HALF * BK, NXCD = 8, WGM = 4;
constexpr int LDS_STAGE = 8 * HT * 2;
constexpr int LDS_TR = LDS_STAGE + 64;
constexpr int LDS_BYTES = LDS_TR + 8 * 2304;

__device__ const double INVF_REV[32] = {
0.15915494309189535, 0.11934937021124886, 0.08949940160889101, 0.06711508300522726, 0.050329212104487035, 0.03774158471741977, 0.0283021958306234, 0.02122365276477766, 0.015915494309189534, 0.011934937021124886, 0.008949940160889102, 0.006711508300522725, 0.005032921210448704, 0.003774158471741977, 0.00283021958306234, 0.0021223652764777662, 0.0015915494309189536, 0.0011934937021124885, 0.0008949940160889102, 0.0006711508300522726, 0.0005032921210448703, 0.00037741584717419774, 0.00028302195830623395, 0.0002122365276477766, 0.00015915494309189535, 0.00011934937021124886, 8.949940160889102e-05, 6.711508300522725e-05, 5.0329212104487035e-05, 3.774158471741978e-05, 2.8302195830623396e-05, 2.122365276477766e-05};

struct Params {
  const float *x, *p; const int* pos;
  const float *ln_ffn1, *w1g, *w1u, *w1d, *ln_mix, *w_in, *lb_logits, *hg_norm, *q_a_norm, *w_q_up, *kv_a_norm, *w_kv_up,
              *w_out, *ln_ffn2, *w2g, *w2u, *w2d, *ln_ple, *w_pg, *w_pp, *ln_final;
  float* out;
  char* ws;
  int ph_lo, ph_hi;
};
constexpr size_t MiB = 1024 * 1024;
constexpr size_t OFF_hb = 0,   OFF_act = 64 * MiB, OFF_Kb = OFF_act, OFF_Vt = OFF_act + 48 * MiB, OFF_cqb = OFF_act + 80 * MiB,
                 OFF_ckvb = OFF_act + 96 * MiB, OFF_sg = OFF_act + 112 * MiB, OFF_vhT = OFF_act + 144 * MiB, OFF_qh = 240 * MiB,
                 OFF_logf = 272 * MiB, OFF_pp = OFF_logf, OFF_pb = 336 * MiB, OFF_cc = 352 * MiB,
                 OFF_W1cat = 416 * MiB, OFF_Wd1t = OFF_W1cat + 11 * MiB, OFF_Wint = OFF_Wd1t + 5632 * 1024, OFF_Wqt = OFF_Wint + 5 * MiB,
                 OFF_Wkvt = OFF_Wqt + 384 * 1024, OFF_Woutt = OFF_Wkvt + 512 * 1024, OFF_W2cat = OFF_Woutt + 2 * MiB, OFF_Wd2t = OFF_W2cat + 11 * MiB,
                 OFF_Wpgt = OFF_Wd2t + 5632 * 1024, OFF_Wppt = OFF_Wpgt + 2 * MiB, OFF_cs = 460 * MiB, OFF_lb = 468 * MiB,
                 OFF_ssq1 = OFF_lb + 64 * 1024, OFF_ssq2 = OFF_ssq1 + 128 * 1024, OFF_ssq3 = OFF_ssq2 + 128 * 1024, OFF_ssq4 = OFF_ssq3 + 128 * 1024,
                 OFF_ssq5 = OFF_ssq4 + 128 * 1024, OFF_ssq_q = OFF_ssq5 + 128 * 1024, OFF_ssq_kv = OFF_ssq_q + 128 * 1024, OFF_ctr = OFF_ssq_kv + 128 * 1024, OFF_pcnt = OFF_ctr + 256, OFF_bar = OFF_pcnt + 768, OFF_ktt = 470 * MiB, OFF_elast = OFF_ktt + 32 * MiB, WS_END = OFF_elast + MiB;
static_assert(OFF_bar + 16384 <= OFF_ktt, "barrier words overlap ktt");
static_assert(OFF_Wppt + 512 * 1024 <= OFF_cs, "weights overlap cs");

typedef __attribute__((address_space(1))) char GCHAR;
extern __shared__ __attribute__((aligned(16))) char smem[];

__device__ __forceinline__ int tid_l() { int t = threadIdx.x; asm volatile("" : "+v"(t)); return t; }
typedef __bf16 bf16v2_t __attribute__((ext_vector_type(2)));
__device__ __forceinline__ unsigned cvt_pk(float lo, float hi) { f32x2 v = {lo, hi}; bf16v2_t r = __builtin_convertvector(v, bf16v2_t); return __builtin_bit_cast(unsigned, r); }
__device__ __forceinline__ float bf2f(unsigned short v) { return __uint_as_float(((unsigned)v) << 16); }
__device__ __forceinline__ float sigmoidf_(float x) { return __builtin_amdgcn_rcpf(1.0f + __expf(-x)); }
__device__ __forceinline__ void atomic_addf(float* p, float v) { __hip_atomic_fetch_add(p, v, __ATOMIC_RELAXED, __HIP_MEMORY_SCOPE_SYSTEM); }

__device__ __forceinline__ int perm32(int rho) { const int n = rho >> 4, i = rho & 15; return 8 * (i >> 2) + 4 * n + (i & 3); }
__device__ __forceinline__ int perm_src(int perm, int n, int& which) {
  which = 0;
  if (perm == 0) return n;
  if (perm == 1) { int pn = n >> 8, bj = (n >> 7) & 1, c = n & 127; which = bj; return pn * 128 + (c & ~31) + perm32(c & 31); }
  if (perm == 4) return (n & ~31) + perm32(n & 31);
  if (perm == 2) { if (n < 2432) return n; if (n < 2496) { int c = n - 2432; return 2432 + (c >> 1) + 32 * (c & 1); } return -1; }
    { if (n < 512) { int h = n >> 7, c = n & 127; return h * 192 + c; } int r = n - 512, h = r >> 6, c = r & 63; return h * 192 + 128 + (c >> 1) + 32 * (c & 1); }
}

__device__ __forceinline__ void prep_weight(const float* __restrict__ W, const float* __restrict__ W2, const float* __restrict__ gain, bf16_t* __restrict__ dst,
                                            const int Ksrc, const int Nsrc, const int Kd, const int Nd, const int perm, const int first, const int stride) {
  const int ntask = Nd * (Kd >> 3);
  for (int t = first; t < ntask; t += stride) {
    const int n = t % Nd, kc = t / Nd;
    int which; const int src = perm_src(perm, n, which);
    const float* Ws = which ? W2 : W;
    float v[8];
#pragma unroll
    for (int i = 0; i < 8; ++i) {
      const int k = kc * 8 + i;
      v[i] = (src >= 0 && k < Ksrc) ? Ws[(size_t)k * Nsrc + src] : 0.f;
    }
    if (gain) {
#pragma unroll
      for (int i = 0; i < 8; ++i) { const int k = kc * 8 + i; if (k < Ksrc) v[i] *= gain[k]; }
    }
    u32x4 o = {cvt_pk(v[0], v[1]), cvt_pk(v[2], v[3]), cvt_pk(v[4], v[5]), cvt_pk(v[6], v[7])};
    *(u32x4*)(dst + (size_t)n * Kd + kc * 8) = o;
  }
}

__device__ __forceinline__ void prep_x(const Params& P, GCHAR* ws_) {
  const int tid = tid_l(), lane = tid & 63, wid = tid >> 6;
  for (int row = (blockIdx.x * 8 + wid) * 2; row < T; row += gridDim.x * 16) {
    f32x4 v[2][4];
#pragma unroll
    for (int r = 0; r < 2; ++r)
#pragma unroll
      for (int i = 0; i < 4; ++i) v[r][i] = *(const f32x4*)(P.x + (size_t)(row + r) * DM + i * 256 + lane * 4);
#pragma unroll
    for (int r = 0; r < 2; ++r) {
      float sq = 0.f;
#pragma unroll
      for (int i = 0; i < 4; ++i) {
        sq += v[r][i][0] * v[r][i][0] + v[r][i][1] * v[r][i][1] + v[r][i][2] * v[r][i][2] + v[r][i][3] * v[r][i][3];
        u32x2 o = {cvt_pk(v[r][i][0], v[r][i][1]), cvt_pk(v[r][i][2], v[r][i][3])};
        *(u32x2*)(((bf16_t*)(ws_ + OFF_hb)) + (size_t)(row + r) * DM + i * 256 + lane * 4) = o;
      }
#pragma unroll
      for (int o = 32; o >= 1; o >>= 1) sq += __shfl_xor(sq, o);
      if (lane == 0) ((float*)(ws_ + OFF_ssq1))[row + r] = sq;
    }
  }
}

__device__ __forceinline__ void prep_weights(const Params& P, GCHAR* ws_) {
  const int first = blockIdx.x * 512 + tid_l(), stride = gridDim.x * 512;
  prep_weight(P.w1g, P.w1u, P.ln_ffn1, ((bf16_t*)(ws_ + OFF_W1cat)), 1024, 2816, 1024, 5632, 1, first, stride);
  prep_weight(P.w1d, nullptr, nullptr, ((bf16_t*)(ws_ + OFF_Wd1t)), 2816, 1024, 2816, 1024, 4, first, stride);
  prep_weight(P.w_in, nullptr, P.ln_mix, ((bf16_t*)(ws_ + OFF_Wint)), 1024, 2496, 1024, 2560, 2, first, stride);
  prep_weight(P.w_q_up, nullptr, P.q_a_norm, ((bf16_t*)(ws_ + OFF_Wqt)), 256, 768, 256, 768, 3, first, stride);
  prep_weight(P.w_kv_up, nullptr, P.kv_a_norm, ((bf16_t*)(ws_ + OFF_Wkvt)), 128, 1024, 256, 1024, 0, first, stride);
  prep_weight(P.w_out, nullptr, nullptr, ((bf16_t*)(ws_ + OFF_Woutt)), 1024, 1024, 1024, 1024, 4, first, stride);
  prep_weight(P.w2g, P.w2u, P.ln_ffn2, ((bf16_t*)(ws_ + OFF_W2cat)), 1024, 2816, 1024, 5632, 1, first, stride);
  prep_weight(P.w2d, nullptr, nullptr, ((bf16_t*)(ws_ + OFF_Wd2t)), 2816, 1024, 2816, 1024, 4, first, stride);
  prep_weight(P.w_pg, nullptr, P.ln_ple, ((bf16_t*)(ws_ + OFF_Wpgt)), 1024, 1024, 1024, 1024, 4, first, stride);
  prep_weight(P.w_pp, nullptr, nullptr, ((bf16_t*)(ws_ + OFF_Wppt)), 256, 1024, 256, 1024, 0, first, stride);
}

__device__ __forceinline__ void phase0(const Params& P) {
  GCHAR* ws_ = (GCHAR*)P.ws; asm volatile("" : "+s"(ws_));
  const int tid = tid_l();
  const int gthreads = gridDim.x * 512, gtid = blockIdx.x * 512 + tid;
  for (int i = gtid; i < 6 * T / 4 + 64; i += gthreads) ((f32x4*)((float*)(ws_ + OFF_ssq2)))[i] = (f32x4){0.f, 0.f, 0.f, 0.f};
  if (gtid < 512) { float l0 = P.lb_logits[gtid], l1 = P.lb_logits[512 + gtid]; ((float*)(ws_ + OFF_lb))[gtid] = 1.f / (1.f + __expf(l1 - l0)); }
  for (int i = gtid; i < T * 32; i += gthreads) {
    const int t = i >> 5, f = i & 31;
    double a = (double)P.pos[t] * INVF_REV[f];
    a -= rint(a);
    const float fr = (float)a;
    f32x2 o = {__builtin_amdgcn_cosf(fr), __builtin_amdgcn_sinf(fr)};
    ((f32x2*)(ws_ + OFF_cs))[i] = o;
  }
  for (int i = gtid; i < T * 256 / 4; i += 4 * gthreads) {
    f32x4 v[4];
#pragma unroll
    for (int u = 0; u < 4; ++u) v[u] = (i + u * gthreads < T * 256 / 4) ? ((const f32x4*)P.p)[i + u * gthreads] : (f32x4){0.f, 0.f, 0.f, 0.f};
#pragma unroll
    for (int u = 0; u < 4; ++u)
      if (i + u * gthreads < T * 256 / 4) { u32x2 o = {cvt_pk(v[u][0], v[u][1]), cvt_pk(v[u][2], v[u][3])}; ((u32x2*)((bf16_t*)(ws_ + OFF_pb)))[i + u * gthreads] = o; }
  }
  if (blockIdx.x & 1) { prep_weights(P, ws_); prep_x(P, ws_); }
  else { prep_x(P, ws_); prep_weights(P, ws_); }
}

__device__ __forceinline__ int lds_byte(int r, int c) {
  int st = (r >> 4) * 2 + (c >> 5), rr = r & 15, cc = c & 31, ob = rr * 64 + cc * 2;
  return st * 1024 + (ob ^ (((ob >> 9) & 1) << 5));
}
__device__ __forceinline__ void stage_rc(int b, int& R, int& C) {
  int st = b / 1024, sb = b % 1024, swz = sb ^ (((sb >> 9) & 1) << 5);
  R = (st >> 1) * 16 + swz / 64; C = (st & 1) * 32 + (swz % 64) / 2;
}

enum { M_SWIGLU = 0, M_RESID = 1, M_WIN = 2, M_QUP = 3, M_KVUP = 4, M_PP = 5, M_PLE = 6 };

struct GemmJob { const bf16_t* A; const bf16_t* Bt; int K; int nN; int mode; int aux; };

#define EPI_GEO const int tid_ = tid_l(); const int wid = __builtin_amdgcn_readfirstlane(tid_ >> 6), lane = tid_ & 63, wr = wid >> 2, wc = wid & 3; int fr = lane & 15, fq = lane >> 4; asm volatile("" : "+v"(fr), "+v"(fq)); (void)wc; (void)wr;

#define LOAD_RS8(invn) float rs8[8]; _Pragma("unroll") for (int r_ = 0; r_ < 8; ++r_) rs8[r_] = rsqrtf(rsraw[r_] * (invn) + 1e-6f);

__device__ __forceinline__ void store_bf4(bf16_t* p, f32x4 v) { u32x2 o = {cvt_pk(v[0], v[1]), cvt_pk(v[2], v[3])}; *(u32x2*)p = o; }


__device__ __forceinline__ void store_tr16(char* wl, const f32x4 (&v)[4], bf16_t* dst, const size_t ld, const int fr, const int fq, const int lane) {
#pragma unroll
  for (int m = 0; m < 4; ++m) {
    const unsigned p0 = cvt_pk(v[m][0], v[m][1]), p1 = cvt_pk(v[m][2], v[m][3]);
    char* w = wl + (fq * 4) * 144 + (m * 16 + fr) * 2;
    *(bf16_t*)(w) = (bf16_t)(p0 & 0xffffu); *(bf16_t*)(w + 144) = (bf16_t)(p0 >> 16);
    *(bf16_t*)(w + 288) = (bf16_t)(p1 & 0xffffu); *(bf16_t*)(w + 432) = (bf16_t)(p1 >> 16);
  }
  asm volatile("s_waitcnt lgkmcnt(0)" ::: "memory");
#pragma unroll
  for (int k = 0; k < 2; ++k) {
    const int chunk = lane + k * 64, col = chunk >> 3, r8 = chunk & 7;
    const u32x4 t = *(const u32x4*)(wl + col * 144 + r8 * 16);
    *(u32x4*)(dst + (size_t)col * ld + r8 * 8) = t;
  }
  asm volatile("s_waitcnt lgkmcnt(0)" ::: "memory");
}

__device__ __forceinline__ void store_bf8(bf16_t* p, f32x4 a, f32x4 b) { u32x4 o = {cvt_pk(a[0], a[1]), cvt_pk(a[2], a[3]), cvt_pk(b[0], b[1]), cvt_pk(b[2], b[3])}; *(u32x4*)p = o; }
__device__ __forceinline__ f32x4 bf_lo4(u32x4 v) { f32x4 r; r[0] = __uint_as_float(v[0] << 16); r[1] = __uint_as_float(v[0] & 0xffff0000u); r[2] = __uint_as_float(v[1] << 16); r[3] = __uint_as_float(v[1] & 0xffff0000u); return r; }
__device__ __forceinline__ f32x4 bf_hi4(u32x4 v) { f32x4 r; r[0] = __uint_as_float(v[2] << 16); r[1] = __uint_as_float(v[2] & 0xffff0000u); r[2] = __uint_as_float(v[3] << 16); r[3] = __uint_as_float(v[3] & 0xffff0000u); return r; }

__device__ __forceinline__ void epi_swiglu(const f32x4 (&acc)[2][2][4][2], int brow, int pn, const float (&rsraw)[8], bf16_t* __restrict__ act) {
  EPI_GEO
  LOAD_RS8(1.f / 1024.f)
#pragma unroll
  for (int ai = 0; ai < 2; ++ai)
#pragma unroll
    for (int m = 0; m < 4; ++m) {
      const int row = brow + ai * 128 + wr * 64 + m * 16 + fr;
      const float rs = rs8[ai * 4 + m];
      f32x4 a[2];
#pragma unroll
      for (int n = 0; n < 2; ++n) {
        const f32x4 g = acc[ai][0][m][n] * rs, u = acc[ai][1][m][n] * rs;
#pragma unroll
        for (int j = 0; j < 4; ++j) a[n][j] = g[j] * sigmoidf_(g[j]) * u[j];
      }
      store_bf8(act + (size_t)row * DFF + pn * 128 + wc * 32 + 8 * fq, a[0], a[1]);
    }
}

__device__ __forceinline__ f32x4 bf4_to_f32(u32x2 v) {
  f32x4 r; r[0] = __uint_as_float(v[0] << 16); r[1] = __uint_as_float(v[0] & 0xffff0000u); r[2] = __uint_as_float(v[1] << 16); r[3] = __uint_as_float(v[1] & 0xffff0000u); return r;
}
template <bool SRC_F32>
__device__ __forceinline__ void epi_resid(const f32x4 (&acc)[2][2][4][2], int brow, int bcol, const float* xsrc, float alpha, bf16_t* hb, float* ssq_next) {
  EPI_GEO
  const size_t base = (size_t)(brow + wr * 64 + fr) * DM + bcol + wc * 32 + 8 * fq;
  f32x4 cur[2][2], nxt[2][2];
#define RESID_LD(dst, off_) _Pragma("unroll") for (int bj = 0; bj < 2; ++bj) { \
    if (SRC_F32) { dst[bj][0] = *(const f32x4*)(xsrc + (off_) + bj * 128); dst[bj][1] = *(const f32x4*)(xsrc + (off_) + bj * 128 + 4); } \
    else { const u32x4 t_ = *(const u32x4*)(hb + (off_) + bj * 128); dst[bj][0] = bf_lo4(t_); dst[bj][1] = bf_hi4(t_); } }
  RESID_LD(cur, base);
#pragma unroll
  for (int r = 0; r < 8; ++r) {
    const int ai = r >> 2, m = r & 3;
    const size_t ro = base + (size_t)(ai * 128 + m * 16) * DM;
    if (r < 7) {
      const size_t rn = base + (size_t)(((r + 1) >> 2) * 128 + ((r + 1) & 3) * 16) * DM;
      RESID_LD(nxt, rn);
    }
    float sq = 0.f;
#pragma unroll
    for (int bj = 0; bj < 2; ++bj) {
      const f32x4 h0 = cur[bj][0] + acc[ai][bj][m][0] * alpha, h1 = cur[bj][1] + acc[ai][bj][m][1] * alpha;
      store_bf8(hb + ro + bj * 128, h0, h1);
      sq += h0[0] * h0[0] + h0[1] * h0[1] + h0[2] * h0[2] + h0[3] * h0[3] + h1[0] * h1[0] + h1[1] * h1[1] + h1[2] * h1[2] + h1[3] * h1[3];
    }
    sq += __shfl_xor(sq, 16); sq += __shfl_xor(sq, 32);
    if (fq == 0) atomic_addf(ssq_next + brow + ai * 128 + wr * 64 + m * 16 + fr, sq);
#pragma unroll
    for (int bj = 0; bj < 2; ++bj)
#pragma unroll
      for (int n = 0; n < 2; ++n) cur[bj][n] = nxt[bj][n];
  }
#undef RESID_LD
}

__device__ __forceinline__ void epi_ple(const f32x4 (&acc)[2][2][4][2], int brow, int bcol, const float (&rsraw)[8], const bf16_t* __restrict__ pp,
                                        const bf16_t* hbsrc, bf16_t* h4b, float* ssq_next) {
  EPI_GEO
  const size_t base = (size_t)(brow + wr * 64 + fr) * DM + bcol + wc * 32 + 8 * fq;
  u32x4 hc[2], hn[2], pc[2], pnx[2];
#pragma unroll
  for (int bj = 0; bj < 2; ++bj) { hc[bj] = *(const u32x4*)(hbsrc + base + bj * 128); pc[bj] = *(const u32x4*)(pp + base + bj * 128); }
#pragma unroll
  for (int r = 0; r < 8; ++r) {
    const int ai = r >> 2, m = r & 3;
    const size_t ro = base + (size_t)(ai * 128 + m * 16) * DM;
    if (r < 7) {
      const size_t rn = base + (size_t)(((r + 1) >> 2) * 128 + ((r + 1) & 3) * 16) * DM;
#pragma unroll
      for (int bj = 0; bj < 2; ++bj) { hn[bj] = *(const u32x4*)(hbsrc + rn + bj * 128); pnx[bj] = *(const u32x4*)(pp + rn + bj * 128); }
    }
    const float rs = rsqrtf(rsraw[r] * (1.f / 1024.f) + 1e-6f);
    float sq = 0.f;
#pragma unroll
    for (int bj = 0; bj < 2; ++bj) {
      f32x4 hv[2] = {bf_lo4(hc[bj]), bf_hi4(hc[bj])};
      const f32x4 pv[2] = {bf_lo4(pc[bj]), bf_hi4(pc[bj])};
#pragma unroll
      for (int n = 0; n < 2; ++n) {
        const f32x4 a = acc[ai][bj][m][n] * rs;
#pragma unroll
        for (int j = 0; j < 4; ++j) hv[n][j] += sigmoidf_(a[j]) * pv[n][j];
        sq += hv[n][0] * hv[n][0] + hv[n][1] * hv[n][1] + hv[n][2] * hv[n][2] + hv[n][3] * hv[n][3];
      }
      store_bf8(h4b + ro + bj * 128, hv[0], hv[1]);
    }
    sq += __shfl_xor(sq, 16); sq += __shfl_xor(sq, 32);
    if (fq == 0) atomic_addf(ssq_next + brow + ai * 128 + wr * 64 + m * 16 + fr, sq);
#pragma unroll
    for (int bj = 0; bj < 2; ++bj) { hc[bj] = hn[bj]; pc[bj] = pnx[bj]; }
  }
}

__device__ __forceinline__ void epi_pp(const f32x4 (&acc)[2][2][4][2], int brow, int bcol, bf16_t* __restrict__ pp) {
  EPI_GEO
#pragma unroll
  for (int ai = 0; ai < 2; ++ai)
#pragma unroll
    for (int m = 0; m < 4; ++m) {
      const int row = brow + ai * 128 + wr * 64 + m * 16 + fr;
#pragma unroll
      for (int bj = 0; bj < 2; ++bj)
#pragma unroll
        for (int n = 0; n < 2; ++n) store_bf4(pp + (size_t)row * DM + bcol + bj * 128 + wc * 32 + n * 16 + fq * 4, acc[ai][bj][m][n]);
    }
}

__device__ __forceinline__ void rope4(f32x4 v, f32x4 cs2, unsigned& o1, unsigned& o2) {
  const float a0 = v[0] * cs2[0] - v[1] * cs2[1], b0 = v[1] * cs2[0] + v[0] * cs2[1];
  const float a1 = v[2] * cs2[2] - v[3] * cs2[3], b1 = v[3] * cs2[2] + v[2] * cs2[3];
  o1 = cvt_pk(a0, a1); o2 = cvt_pk(b0, b1);
}

__device__ __forceinline__ void epi_win(const f32x4 (&acc)[2][2][4][2], int brow, int pn, const float (&rsraw)[8], const Params& P) {
  GCHAR* ws_ = (GCHAR*)P.ws; asm volatile("" : "+s"(ws_));
  EPI_GEO
  LOAD_RS8(1.f / 1024.f)
  if (pn == 4 || pn == 5) {
    char* wl = smem + LDS_TR + wid * 2304;
#pragma unroll
    for (int ai = 0; ai < 2; ++ai)
#pragma unroll
      for (int bj = 0; bj < 2; ++bj)
#pragma unroll
        for (int n = 0; n < 2; ++n) {
          f32x4 v[4];
#pragma unroll
          for (int m = 0; m < 4; ++m) v[m] = acc[ai][bj][m][n] * rs8[ai * 4 + m];
          const int col0 = (pn - 4) * 256 + bj * 128 + wc * 32 + n * 16, row0 = brow + ai * 128 + wr * 64;
          store_tr16(wl, v, ((bf16_t*)(ws_ + OFF_vhT)) + (size_t)col0 * T + row0, (size_t)T, fr, fq, lane);
        }
    return;
  }
  f32x4 lb4[2][2];
#pragma unroll
  for (int bj = 0; bj < 2; ++bj)
#pragma unroll
    for (int n = 0; n < 2; ++n)
      lb4[bj][n] = (pn == 2 || pn == 3) ? *(const f32x4*)(((float*)(ws_ + OFF_lb)) + (pn - 2) * 256 + bj * 128 + wc * 32 + n * 16 + fq * 4) : (f32x4){0.f, 0.f, 0.f, 0.f};
#pragma unroll
  for (int ai = 0; ai < 2; ++ai)
#pragma unroll
    for (int m = 0; m < 4; ++m) {
      const int row = brow + ai * 128 + wr * 64 + m * 16 + fr;
      const float rs = rs8[ai * 4 + m];
      float sq0 = 0.f;
#pragma unroll
      for (int bj = 0; bj < 2; ++bj)
#pragma unroll
        for (int n = 0; n < 2; ++n) {
          const int c = bj * 128 + wc * 32 + n * 16 + fq * 4;
          f32x4 v = acc[ai][bj][m][n] * rs;
          if (pn < 2) {
            store_bf4(((bf16_t*)(ws_ + OFF_qh)) + (size_t)row * 512 + pn * 256 + c, v);
          } else if (pn < 4) {
            const int d = (pn - 2) * 256 + c;
            const f32x4 lbv = lb4[bj][n]; f32x4 o;
#pragma unroll
            for (int j = 0; j < 4; ++j) o[j] = lbv[j] + (1.f - lbv[j]) * sigmoidf_(v[j]);
            *(f32x4*)(((float*)(ws_ + OFF_logf)) + (size_t)row * 512 + d) = o;
          } else if (pn < 8) {
            f32x4 o;
#pragma unroll
            for (int j = 0; j < 4; ++j) o[j] = v[j] * sigmoidf_(v[j]);
            store_bf4(((bf16_t*)(ws_ + OFF_sg)) + (size_t)row * 512 + (pn - 6) * 256 + c, o);
          } else if (pn == 8) {
            store_bf4(((bf16_t*)(ws_ + OFF_cqb)) + (size_t)row * 256 + c, v);
            sq0 += v[0] * v[0] + v[1] * v[1] + v[2] * v[2] + v[3] * v[3];
          } else {
            if (bj == 0) {
              store_bf4(((bf16_t*)(ws_ + OFF_ckvb)) + (size_t)row * 256 + c, v);
              sq0 += v[0] * v[0] + v[1] * v[1] + v[2] * v[2] + v[3] * v[3];
            } else {
              *(u32x2*)(((bf16_t*)(ws_ + OFF_ckvb)) + (size_t)row * 256 + c) = (u32x2){0u, 0u};
              if (wc < 2) {
                const int i0 = wc * 16 + n * 8 + fq * 2;
                f32x4 cs2 = *(const f32x4*)(((f32x2*)(ws_ + OFF_cs)) + (size_t)row * 32 + i0);
                unsigned o1, o2; rope4(v, cs2, o1, o2);
#pragma unroll
                for (int h = 0; h < 4; ++h) {
                  *(unsigned*)(((bf16_t*)(ws_ + OFF_Kb)) + (size_t)row * 768 + h * 192 + 128 + i0) = o1;
                  *(unsigned*)(((bf16_t*)(ws_ + OFF_Kb)) + (size_t)row * 768 + h * 192 + 160 + i0) = o2;
                }
              }
            }
          }
        }
      if (pn >= 8) {
        sq0 += __shfl_xor(sq0, 16); sq0 += __shfl_xor(sq0, 32);
        if (fq == 0) atomic_addf((pn == 8 ? ((float*)(ws_ + OFF_ssq_q)) : ((float*)(ws_ + OFF_ssq_kv))) + row, sq0);
      }
    }
}

__device__ __forceinline__ void epi_qup(const f32x4 (&acc)[2][2][4][2], int brow, int pn, const float (&rsraw)[8], const Params& P) {
  GCHAR* ws_ = (GCHAR*)P.ws; asm volatile("" : "+s"(ws_));
  EPI_GEO
  LOAD_RS8(1.f / 256.f)
  const float qscale = 0.07216878364870322f * 1.4426950408889634f;
#pragma unroll
  for (int ai = 0; ai < 2; ++ai)
#pragma unroll
    for (int m = 0; m < 4; ++m) {
      const int row = brow + ai * 128 + wr * 64 + m * 16 + fr;
      const float rs = rs8[ai * 4 + m] * qscale;
#pragma unroll
      for (int bj = 0; bj < 2; ++bj)
#pragma unroll
        for (int n = 0; n < 2; ++n) {
          f32x4 v = acc[ai][bj][m][n] * rs;
          if (pn < 2) {
            const int h = pn * 2 + bj, c = wc * 32 + n * 16 + fq * 4;
            store_bf4(((bf16_t*)P.out) + (size_t)row * 768 + h * 192 + c, v);
          } else {
            const int h = bj * 2 + (wc >> 1), i0 = (wc & 1) * 16 + n * 8 + fq * 2;
            f32x4 cs2 = *(const f32x4*)(((f32x2*)(ws_ + OFF_cs)) + (size_t)row * 32 + i0);
            unsigned o1, o2; rope4(v, cs2, o1, o2);
            *(unsigned*)(((bf16_t*)P.out) + (size_t)row * 768 + h * 192 + 128 + i0) = o1;
            *(unsigned*)(((bf16_t*)P.out) + (size_t)row * 768 + h * 192 + 160 + i0) = o2;
          }
        }
    }
}

__device__ __forceinline__ void epi_kvup(const f32x4 (&acc)[2][2][4][2], int brow, int pn, const float (&rsraw)[8], const Params& P) {
  GCHAR* ws_ = (GCHAR*)P.ws; asm volatile("" : "+s"(ws_));
  EPI_GEO
  const int brow_ = brow; (void)brow_;
  LOAD_RS8(1.f / 128.f)
  const int h = pn;
#pragma unroll
  for (int ai = 0; ai < 2; ++ai)
#pragma unroll
    for (int m = 0; m < 4; ++m) {
      {
        const int row = brow + ai * 128 + wr * 64 + m * 16 + fr;
        const float rs = rs8[ai * 4 + m];
#pragma unroll
        for (int n = 0; n < 2; ++n) store_bf4(((bf16_t*)(ws_ + OFF_Kb)) + (size_t)row * 768 + h * 192 + wc * 32 + n * 16 + fq * 4, acc[ai][0][m][n] * rs);
      }
    }
  {
    char* wl = smem + LDS_TR + wid * 2304;
#pragma unroll
    for (int ai = 0; ai < 2; ++ai)
#pragma unroll
      for (int n = 0; n < 2; ++n) {
        f32x4 v[4];
#pragma unroll
        for (int m = 0; m < 4; ++m) v[m] = acc[ai][1][m][n] * rs8[ai * 4 + m];
        const int row0 = brow + ai * 128 + wr * 64, b = row0 >> 11, sp0 = row0 & 2047, dv0 = wc * 32 + n * 16;
        store_tr16(wl, v, ((bf16_t*)(ws_ + OFF_Vt)) + ((size_t)(b * 4 + h) * 128 + dv0) * SEQ + sp0, (size_t)SEQ, fr, fq, lane);
      }
  }
}

__device__ __forceinline__ GemmJob mkjob(const bf16_t* A, const bf16_t* Bt, int K, int nN, int mode, int aux) { GemmJob j; j.A = A; j.Bt = Bt; j.K = K; j.nN = nN; j.mode = mode; j.aux = aux; return j; }


#define LAS __attribute__((address_space(3)))
struct Unit { const char* A; const char* B; int pm, pn, mode, aux; };

__device__ __forceinline__ bool next_unit(const GemmJob& j0, const GemmJob& j1, int i, Unit& u) {
  const int n0 = 128 * j0.nN, n1 = 128 * j1.nN;
  int l = i * (int)gridDim.x + (int)blockIdx.x;
  if (l >= n0 + n1) return false;
  const bool second = l >= n0;
  if (second) l -= n0;
  const int nN = second ? j1.nN : j0.nN;
  const int nM = 128, nwg = nM * nN;
  int wgid = l;
  { const int q = nwg / NXCD, r = nwg % NXCD, xcd = wgid % NXCD, off = wgid / NXCD; wgid = (xcd < r ? xcd * (q + 1) : r * (q + 1) + (xcd - r) * q) + off; }
  const int nig = WGM * nN, gid = wgid / nig, fm = gid * WGM, gsz = min(nM - fm, WGM);
  u.pm = fm + ((wgid % nig) % gsz); u.pn = (wgid % nig) / gsz;
  u.A = (const char*)(second ? j1.A : j0.A); u.B = (const char*)(second ? j1.Bt : j0.Bt);
  u.mode = second ? j1.mode : j0.mode; u.aux = second ? j1.aux : j0.aux;
  return true;
}

__device__ __forceinline__ void run_epilogue(const Params& P, const f32x4 (&acc)[2][2][4][2], const Unit& u, const float (&rsraw)[8]) {
  GCHAR* ws_ = (GCHAR*)P.ws; asm volatile("" : "+s"(ws_));
  const int brow = u.pm * BM, bcol = u.pn * BM, pn = u.pn;
  switch (u.mode) {
    case M_SWIGLU: epi_swiglu(acc, brow, pn, rsraw, ((bf16_t*)(ws_ + OFF_act))); break;
    case M_RESID:
      if (u.aux == 0) epi_resid<true>(acc, brow, bcol, P.x, 0.5f, ((bf16_t*)(ws_ + OFF_hb)), ((float*)(ws_ + OFF_ssq2)));
      else if (u.aux == 1) epi_resid<false>(acc, brow, bcol, nullptr, 1.0f, ((bf16_t*)(ws_ + OFF_hb)), ((float*)(ws_ + OFF_ssq3)));
      else epi_resid<false>(acc, brow, bcol, nullptr, 0.5f, ((bf16_t*)(ws_ + OFF_hb)), ((float*)(ws_ + OFF_ssq4)));
      break;
    case M_WIN: epi_win(acc, brow, pn, rsraw, P); break;
    case M_QUP: epi_qup(acc, brow, pn, rsraw, P); break;
    case M_KVUP: epi_kvup(acc, brow, pn, rsraw, P); break;
    case M_PP: epi_pp(acc, brow, bcol, ((bf16_t*)(ws_ + OFF_pp))); break;
    default: epi_ple(acc, brow, bcol, rsraw, ((bf16_t*)(ws_ + OFF_pp)), ((const bf16_t*)(ws_ + OFF_hb)), ((bf16_t*)(ws_ + OFF_cc)), ((float*)(ws_ + OFF_ssq5))); break;
  }
}

__device__ __forceinline__ void gemm_phase(const Params& P, const GemmJob j0, const GemmJob j1) {
  LAS unsigned char* lds = (LAS unsigned char*)smem;
  const int tid = tid_l(), wid = __builtin_amdgcn_readfirstlane(tid >> 6), lane = tid & 63, wr = wid >> 2, wc = wid & 3, fr = lane & 15, fq = lane >> 4;
  const int K = j0.K, nt = K / BK;
  constexpr int HTB = HALF * BK * 2;
  unsigned voff[2];
#pragma unroll
  for (int i = 0; i < 2; ++i) { int R, C; stage_rc(tid * 16 + i * 8192, R, C); voff[i] = (unsigned)(R * K + C) * 2u; }
  const size_t kstep = (size_t)(BK * 2), hstep = (size_t)HALF * K * 2, tstep = 2 * hstep;
  const unsigned ldsw = (unsigned)wid * 1024u;
  const int aoff = lds_byte(wr * 64 + fr, fq * 8), boff = lds_byte(wc * 32 + fr, fq * 8);
#define G_SA(b, h) (((b) * 2 + (h)) * HTB)
#define G_SB(b, h) ((4 + (b) * 2 + (h)) * HTB)
#define G_STAGE(bufoff, gbase) do { _Pragma("unroll") for (int _i = 0; _i < 2; ++_i) \
    __builtin_amdgcn_global_load_lds((const unsigned*)((const char*)(gbase) + voff[_i]), (LAS unsigned*)(lds + (bufoff) + ldsw + _i * 8192), 16, 0, 0); } while (0)
#define G_LDA(dst, b, h) do { _Pragma("unroll") for (int m = 0; m < 4; ++m) _Pragma("unroll") for (int k = 0; k < 2; ++k) dst[m][k] = *(const LAS bf16x8*)(lds + G_SA(b, h) + aoff + m * 2048 + k * 1024); } while (0)
#define G_LDB(dst, b, h) do { _Pragma("unroll") for (int n = 0; n < 2; ++n) _Pragma("unroll") for (int k = 0; k < 2; ++k) dst[n][k] = *(const LAS bf16x8*)(lds + G_SB(b, h) + boff + n * 2048 + k * 1024); } while (0)
#define G_MMA(ai, bj, At_, Bt_) do { __builtin_amdgcn_s_setprio(1); _Pragma("unroll") for (int m = 0; m < 4; ++m) _Pragma("unroll") for (int n = 0; n < 2; ++n) _Pragma("unroll") for (int k = 0; k < 2; ++k) \
    acc[ai][bj][m][n] = __builtin_amdgcn_mfma_f32_16x16x32_bf16(Bt_[n][k], At_[m][k], acc[ai][bj][m][n], 0, 0, 0); __builtin_amdgcn_s_setprio(0); } while (0)
#define G_WAIT_V(n) asm volatile("s_waitcnt vmcnt(" #n ")" ::: "memory")
#define G_WAIT_L(n) asm volatile("s_waitcnt lgkmcnt(" #n ")" ::: "memory")
#define G_BAR __builtin_amdgcn_s_barrier()
#define G_SCHED __builtin_amdgcn_sched_barrier(0)
  Unit cur, nxt; int ui = 0;
  if (!next_unit(j0, j1, 0, cur)) return;
  f32x4 acc[2][2][4][2];
#pragma unroll
  for (int a = 0; a < 2; ++a)
#pragma unroll
    for (int b = 0; b < 2; ++b)
#pragma unroll
      for (int m = 0; m < 4; ++m)
#pragma unroll
        for (int n = 0; n < 2; ++n) acc[a][b][m][n] = (f32x4){0.f, 0.f, 0.f, 0.f};
  bf16x8 At[4][2], B0[2][2], B1[2][2];
  float rsraw[8];
#pragma unroll
  for (int r_ = 0; r_ < 8; ++r_) rsraw[r_] = 0.f;
  const char* cA = cur.A + (size_t)cur.pm * tstep; const char* cB = cur.B + (size_t)cur.pn * tstep;
  G_STAGE(G_SB(0, 0), cB); G_STAGE(G_SA(0, 0), cA); G_STAGE(G_SB(0, 1), cB + hstep); G_STAGE(G_SA(0, 1), cA + hstep);
  if (wr == 1) G_BAR;
  G_WAIT_V(4); G_BAR;
  G_STAGE(G_SB(1, 0), cB + kstep); G_STAGE(G_SA(1, 0), cA + kstep); G_STAGE(G_SB(1, 1), cB + hstep + kstep);
  G_WAIT_V(6); G_BAR;
  for (;;) {
    const bool has_next = next_unit(j0, j1, ui + 1, nxt);
    const char* nA = has_next ? nxt.A + (size_t)nxt.pm * tstep : cA; const char* nB = has_next ? nxt.B + (size_t)nxt.pn * tstep : cB;
    for (int t = 0; t < nt; t += 2) {
      const bool last = (t == nt - 2);
      if (last) {
        GCHAR* wsl = (GCHAR*)P.ws; asm volatile("" : "+s"(wsl));
        size_t so;
        switch (cur.mode) {
          case M_SWIGLU: so = cur.aux ? OFF_ssq3 : OFF_ssq1; break;
          case M_WIN: so = OFF_ssq2; break;
          case M_QUP: so = OFF_ssq_q; break;
          case M_KVUP: so = OFF_ssq_kv; break;
          case M_PLE: so = OFF_ssq4; break;
          default: so = OFF_ssq1; break;
        }
        const float* sp = (const float*)(wsl + so) + cur.pm * BM + wr * 64 + fr;
#pragma unroll
        for (int r_ = 0; r_ < 8; ++r_) rsraw[r_] = sp[(r_ >> 2) * 128 + (r_ & 3) * 16];
      }
      const char* a1 = cA + (size_t)(t + 1) * kstep;
      const char* a2 = last ? nA : cA + (size_t)(t + 2) * kstep; const char* b2 = last ? nB : cB + (size_t)(t + 2) * kstep;
      const char* a3 = a2 + kstep; const char* b3 = b2 + kstep;
      G_LDB(B0, 0, 0); G_SCHED; G_LDA(At, 0, 0); G_STAGE(G_SA(1, 1), a1 + hstep);
      G_WAIT_L(8); G_BAR; G_WAIT_L(0); G_MMA(0, 0, At, B0); G_BAR; G_SCHED;
      G_LDB(B1, 0, 1); G_STAGE(G_SB(0, 0), b2);
      G_BAR; G_WAIT_L(0); G_MMA(0, 1, At, B1); G_BAR;
      G_LDA(At, 0, 1); G_STAGE(G_SA(0, 0), a2);
      G_BAR; G_WAIT_L(0); G_MMA(1, 0, At, B0); G_BAR; G_SCHED;
      G_STAGE(G_SB(0, 1), b2 + hstep);
      G_WAIT_V(6); G_BAR; G_MMA(1, 1, At, B1); G_BAR;
      G_LDB(B0, 1, 0); G_SCHED; G_LDA(At, 1, 0); G_STAGE(G_SA(0, 1), a2 + hstep);
      G_WAIT_L(8); G_BAR; G_WAIT_L(0); G_MMA(0, 0, At, B0); G_BAR; G_SCHED;
      G_LDB(B1, 1, 1); G_STAGE(G_SB(1, 0), b3);
      G_BAR; G_WAIT_L(0); G_MMA(0, 1, At, B1); G_BAR;
      G_LDA(At, 1, 1); G_STAGE(G_SA(1, 0), a3);
      G_BAR; G_WAIT_L(0); G_MMA(1, 0, At, B0); G_BAR; G_SCHED;
      G_STAGE(G_SB(1, 1), b3 + hstep);
      G_WAIT_V(6); G_BAR; G_MMA(1, 1, At, B1); G_BAR;
    }
    run_epilogue(P, acc, cur, rsraw);
    if (!has_next) break;
#pragma unroll
    for (int a = 0; a < 2; ++a)
#pragma unroll
      for (int b = 0; b < 2; ++b)
#pragma unroll
        for (int m = 0; m < 4; ++m)
#pragma unroll
          for (int n = 0; n < 2; ++n) acc[a][b][m][n] = (f32x4){0.f, 0.f, 0.f, 0.f};
    cur = nxt; cA = nA; cB = nB; ++ui;
  }
  G_WAIT_V(0);
  if (wr == 0) G_BAR;
  G_BAR;
#undef G_SA
#undef G_SB
#undef G_STAGE
#undef G_LDA
#undef G_LDB
#undef G_MMA
}


#define LDS_BARRIER() do { asm volatile("s_waitcnt lgkmcnt(0)" ::: "memory"); __builtin_amdgcn_s_barrier(); asm volatile("" ::: "memory"); } while (0)

constexpr int HG_QT = 0, HG_KT = 17408, HG_KTT = 34816, HG_VT = 53248, HG_PART = 71680, HG_EL = 73728, HG_P = 74240;

constexpr int PP_BL = 0, PP_QR = 32768, PP_QT = 50176, PP_KT = 67584, PP_KTT = 84992;
__device__ __forceinline__ void hgrn_prepass(const Params& P) {
  GCHAR* ws_ = (GCHAR*)P.ws; asm volatile("" : "+s"(ws_));
  const int tid = tid_l(), d = tid & 127, seg = tid >> 7;
  float* bL = (float*)(smem + PP_BL);
  f32x4 lg[4]; u32x4 qq[2];
  const bool bal = (gridDim.x == 256);
  const int nit = bal ? (blockIdx.x < 128 ? 6 : 10) : (2048 - (int)blockIdx.x + (int)gridDim.x - 1) / (int)gridDim.x;
#define PP_ITEM(k_) (bal ? ((k_) < 6 ? (k_) * 256 + (int)blockIdx.x : 1536 + ((k_) - 6) * 128 + ((int)blockIdx.x - 128)) : (k_) * (int)gridDim.x + (int)blockIdx.x)
#define PP_LOAD(item_) do { const int bh_ = (item_) >> 5, c_ = (item_) & 31, b_ = bh_ >> 2, h_ = bh_ & 3; const size_t t0_ = (size_t)b_ * SEQ + c_ * 64; \
    _Pragma("unroll") for (int r = 0; r < 4; ++r) lg[r] = *(const f32x4*)(((const float*)(ws_ + OFF_logf)) + (t0_ + (tid >> 5) + r * 16) * 512 + h_ * 128 + (tid & 31) * 4); \
    _Pragma("unroll") for (int r = 0; r < 2; ++r) qq[r] = *(const u32x4*)(((const bf16_t*)(ws_ + OFF_qh)) + (t0_ + (tid >> 4) + r * 32) * 512 + h_ * 128 + (tid & 15) * 8); } while (0)
  if (nit > 0) PP_LOAD(PP_ITEM(0));
  __syncthreads();
  for (int k = 0; k < nit; ++k) {
    const int it = PP_ITEM(k);
    const int bh = it >> 5, c = it & 31, b = bh >> 2, h = bh & 3;
    const size_t t0 = (size_t)b * SEQ + c * 64;
#pragma unroll
    for (int r = 0; r < 4; ++r) *(f32x4*)(bL + ((tid >> 5) + r * 16) * 128 + (tid & 31) * 4) = lg[r];
#pragma unroll
    for (int r = 0; r < 2; ++r) *(u32x4*)(smem + PP_QR + ((tid >> 4) + r * 32) * 272 + (tid & 15) * 16) = qq[r];
    if (k + 1 < nit) PP_LOAD(PP_ITEM(k + 1));
    LDS_BARRIER();
    {
      float p = 1.f;
#pragma unroll
      for (int sgm = 0; sgm < 3; ++sgm)
        if (sgm < seg) {
#pragma unroll
          for (int i = 0; i < 16; ++i) p *= bL[(sgm * 16 + i) * 128 + d];
        }
      unsigned kt_pk[8];
      float kprev = 0.f;
#pragma unroll
      for (int i = 0; i < 16; ++i) {
        const int t = seg * 16 + i;
        const float f = bL[t * 128 + d];
        p *= f;
        const float q = bf2f(*(const bf16_t*)(smem + PP_QR + t * 272 + d * 2));
        const float qt = q * p, kt = (1.f - f) * __builtin_amdgcn_rcpf(p);
        const unsigned qk = cvt_pk(qt, kt);
        *(bf16_t*)(smem + PP_QT + t * 272 + d * 2) = (bf16_t)(qk & 0xffffu);
        *(bf16_t*)(smem + PP_KT + t * 272 + d * 2) = (bf16_t)(qk >> 16);
        if (i & 1) kt_pk[i >> 1] = cvt_pk(kprev, kt); else kprev = kt;
      }
      if (seg == 3) ((float*)(ws_ + OFF_elast))[(size_t)it * 128 + d] = p;
      *(u32x4*)(smem + PP_KTT + d * 128 + seg * 32) = (u32x4){kt_pk[0], kt_pk[1], kt_pk[2], kt_pk[3]};
      *(u32x4*)(smem + PP_KTT + d * 128 + seg * 32 + 16) = (u32x4){kt_pk[4], kt_pk[5], kt_pk[6], kt_pk[7]};
    }
    LDS_BARRIER();
#pragma unroll
    for (int r = 0; r < 2; ++r) {
      const int row = (tid >> 4) + r * 32, ch = tid & 15;
      *(u32x4*)(((bf16_t*)(ws_ + OFF_qh)) + (t0 + row) * 512 + h * 128 + ch * 8) = *(const u32x4*)(smem + PP_QT + row * 272 + ch * 16);
      *(u32x4*)((bf16_t*)(((float*)(ws_ + OFF_logf)) + (t0 + row) * 512 + h * 128) + ch * 8) = *(const u32x4*)(smem + PP_KT + row * 272 + ch * 16);
      *(u32x4*)(((bf16_t*)(ws_ + OFF_ktt)) + (size_t)it * 8192 + (tid + r * 512) * 8) = *(const u32x4*)(smem + PP_KTT + (tid + r * 512) * 16);
    }
  }
#undef PP_ITEM
#undef PP_LOAD
  __syncthreads();
}

__device__ __forceinline__ void hgrn_item(const Params& P, const int bh) {
  GCHAR* ws_ = (GCHAR*)P.ws; asm volatile("" : "+s"(ws_));
  const int b = bh >> 2, h = bh & 3;
  const int tid = tid_l(), wid = tid >> 6, lane = tid & 63, fr = lane & 15, fq = lane >> 4;
  float* part = (float*)(smem + HG_PART);
  float* elast = (float*)(smem + HG_EL);
  f32x4 S[8];
#pragma unroll
  for (int i = 0; i < 8; ++i) S[i] = (f32x4){0.f, 0.f, 0.f, 0.f};
  const f32x4 gain4 = *(const f32x4*)(P.hg_norm + h * 128 + wid * 16 + fq * 4);
  const bf16_t* qp = ((bf16_t*)(ws_ + OFF_qh)) + (size_t)(b * SEQ + (tid >> 4)) * 512 + h * 128 + (tid & 15) * 8;
  const bf16_t* kp_ = (const bf16_t*)(((float*)(ws_ + OFF_logf)) + (size_t)(b * SEQ + (tid >> 4)) * 512 + h * 128) + (tid & 15) * 8;
  const bf16_t* ktp = ((bf16_t*)(ws_ + OFF_ktt)) + (size_t)bh * 32 * 8192 + tid * 8;
  const bf16_t* vp = ((bf16_t*)(ws_ + OFF_vhT)) + (size_t)(h * 128 + (tid >> 3)) * T + b * SEQ + (tid & 7) * 8;
  const float* elp = ((float*)(ws_ + OFF_elast)) + (size_t)bh * 32 * 128 + (tid & 127);
  const bf16_t* sgp = ((bf16_t*)(ws_ + OFF_sg)) + (size_t)(b * SEQ + fr) * 512 + h * 128 + wid * 16 + fq * 4;
  u32x4 qq[2], kk[2], kt2[2], vv[2]; float elv;
#pragma unroll
  for (int r = 0; r < 2; ++r) {
    qq[r] = *(const u32x4*)(qp + (size_t)r * 32 * 512); kk[r] = *(const u32x4*)(kp_ + (size_t)r * 32 * 1024);
    kt2[r] = *(const u32x4*)(ktp + r * 4096); vv[r] = *(const u32x4*)(vp + (size_t)r * 64 * T);
  }
  elv = *elp;
  __syncthreads();
  for (int c = 0; c < 32; ++c) {
    const int t0 = b * SEQ + c * 64;
#pragma unroll
    for (int r = 0; r < 2; ++r) {
      *(u32x4*)(smem + HG_QT + ((tid >> 4) + r * 32) * 272 + (tid & 15) * 16) = qq[r];
      *(u32x4*)(smem + HG_KT + ((tid >> 4) + r * 32) * 272 + (tid & 15) * 16) = kk[r];
      *(u32x4*)(smem + HG_KTT + ((tid >> 3) + r * 64) * 144 + (tid & 7) * 16) = kt2[r];
      *(u32x4*)(smem + HG_VT + ((tid >> 3) + r * 64) * 144 + (tid & 7) * 16) = vv[r];
    }
    if (tid < 128) elast[tid] = elv;
    u32x2 sgv[4];
#pragma unroll
    for (int tt = 0; tt < 4; ++tt) sgv[tt] = *(const u32x2*)(sgp + (size_t)(c * 64 + tt * 16) * 512);
    if (c + 1 < 32) {
#pragma unroll
      for (int r = 0; r < 2; ++r) {
        qq[r] = *(const u32x4*)(qp + (size_t)((c + 1) * 64 + r * 32) * 512); kk[r] = *(const u32x4*)(kp_ + (size_t)((c + 1) * 64 + r * 32) * 1024);
        kt2[r] = *(const u32x4*)(ktp + (size_t)(c + 1) * 8192 + r * 4096); vv[r] = *(const u32x4*)(vp + (size_t)r * 64 * T + (c + 1) * 64);
      }
      elv = elp[(c + 1) * 128];
    }
    LDS_BARRIER();
    bf16x8 Sf[4];
#pragma unroll
    for (int ks = 0; ks < 4; ++ks) {
      u32x4 u = {cvt_pk(S[2 * ks][0], S[2 * ks][1]), cvt_pk(S[2 * ks][2], S[2 * ks][3]), cvt_pk(S[2 * ks + 1][0], S[2 * ks + 1][1]), cvt_pk(S[2 * ks + 1][2], S[2 * ks + 1][3])};
      Sf[ks] = __builtin_bit_cast(bf16x8, u);
    }
    f32x4 o[4];
    {
      const int wu = __builtin_amdgcn_readfirstlane(wid);
      for (int pi = wu; pi < 10; pi += 8) {
        const int tt = (pi >= 6) ? 3 : (pi >= 3) ? 2 : (pi >= 1) ? 1 : 0, st = pi - ((tt * (tt + 1)) >> 1);
        bf16x8 kf4[4], qf4[4];
#pragma unroll
        for (int ks = 0; ks < 4; ++ks) {
          kf4[ks] = *(const bf16x8*)(smem + HG_KT + (st * 16 + fr) * 272 + (ks * 32 + fq * 8) * 2);
          qf4[ks] = *(const bf16x8*)(smem + HG_QT + (tt * 16 + fr) * 272 + (ks * 32 + fq * 8) * 2);
        }
        f32x4 sc = (f32x4){0.f, 0.f, 0.f, 0.f};
#pragma unroll
        for (int ks = 0; ks < 4; ++ks) sc = __builtin_amdgcn_mfma_f32_16x16x32_bf16(kf4[ks], qf4[ks], sc, 0, 0, 0);
        if (st == tt) {
#pragma unroll
          for (int j = 0; j < 4; ++j) if (fq * 4 + j > fr) sc[j] = 0.f;
        }
        char* dstp = smem + HG_P + (tt * 2 + (st >> 1)) * 1024 + lane * 16 + (st & 1) * 8;
        *(u32x2*)dstp = (u32x2){cvt_pk(sc[0], sc[1]), cvt_pk(sc[2], sc[3])};
        if (!(st & 1) && st + 1 > tt) *(u32x2*)(dstp + 8) = (u32x2){0u, 0u};
      }
      bf16x8 vuA[2], quA[4][4];
#pragma unroll
      for (int kp = 0; kp < 2; ++kp) {
        const u32x2 v0 = *(const u32x2*)(smem + HG_VT + (wid * 16 + fr) * 144 + ((2 * kp) * 16 + fq * 4) * 2);
        const u32x2 v1 = *(const u32x2*)(smem + HG_VT + (wid * 16 + fr) * 144 + ((2 * kp + 1) * 16 + fq * 4) * 2);
        u32x4 vu = {v0[0], v0[1], v1[0], v1[1]};
        vuA[kp] = __builtin_bit_cast(bf16x8, vu);
      }
#pragma unroll
      for (int tt = 0; tt < 4; ++tt)
#pragma unroll
        for (int ks = 0; ks < 4; ++ks) {
          const u32x2 q0 = *(const u32x2*)(smem + HG_QT + (tt * 16 + fr) * 272 + ((2 * ks) * 16 + fq * 4) * 2);
          const u32x2 q1 = *(const u32x2*)(smem + HG_QT + (tt * 16 + fr) * 272 + ((2 * ks + 1) * 16 + fq * 4) * 2);
          u32x4 qu = {q0[0], q0[1], q1[0], q1[1]};
          quA[tt][ks] = __builtin_bit_cast(bf16x8, qu);
        }
#pragma unroll
      for (int tt = 0; tt < 4; ++tt) o[tt] = (f32x4){0.f, 0.f, 0.f, 0.f};
#pragma unroll
      for (int ks = 0; ks < 4; ++ks)
#pragma unroll
        for (int tt = 0; tt < 4; ++tt) o[tt] = __builtin_amdgcn_mfma_f32_16x16x32_bf16(Sf[ks], quA[tt][ks], o[tt], 0, 0, 0);
      LDS_BARRIER();
      bf16x8 pf[6];
      pf[0] = *(const bf16x8*)(smem + HG_P + 0 * 1024 + lane * 16);
      pf[1] = *(const bf16x8*)(smem + HG_P + 2 * 1024 + lane * 16);
      pf[2] = *(const bf16x8*)(smem + HG_P + 4 * 1024 + lane * 16);
      pf[3] = *(const bf16x8*)(smem + HG_P + 5 * 1024 + lane * 16);
      pf[4] = *(const bf16x8*)(smem + HG_P + 6 * 1024 + lane * 16);
      pf[5] = *(const bf16x8*)(smem + HG_P + 7 * 1024 + lane * 16);
      o[0] = __builtin_amdgcn_mfma_f32_16x16x32_bf16(vuA[0], pf[0], o[0], 0, 0, 0);
      o[1] = __builtin_amdgcn_mfma_f32_16x16x32_bf16(vuA[0], pf[1], o[1], 0, 0, 0);
      o[2] = __builtin_amdgcn_mfma_f32_16x16x32_bf16(vuA[0], pf[2], o[2], 0, 0, 0);
      o[3] = __builtin_amdgcn_mfma_f32_16x16x32_bf16(vuA[0], pf[4], o[3], 0, 0, 0);
      o[2] = __builtin_amdgcn_mfma_f32_16x16x32_bf16(vuA[1], pf[3], o[2], 0, 0, 0);
      o[3] = __builtin_amdgcn_mfma_f32_16x16x32_bf16(vuA[1], pf[5], o[3], 0, 0, 0);
      float sq[4];
#pragma unroll
      for (int tt = 0; tt < 4; ++tt) sq[tt] = o[tt][0] * o[tt][0] + o[tt][1] * o[tt][1] + o[tt][2] * o[tt][2] + o[tt][3] * o[tt][3];
#pragma unroll
      for (int tt = 0; tt < 4; ++tt) sq[tt] += __shfl_xor(sq[tt], 16);
#pragma unroll
      for (int tt = 0; tt < 4; ++tt) sq[tt] += __shfl_xor(sq[tt], 32);
      if (fq == 0) {
#pragma unroll
        for (int tt = 0; tt < 4; ++tt) part[wid * 64 + tt * 16 + fr] = sq[tt];
      }
    }
    {
      bf16x8 vf[2], kfS[8][2];
      f32x4 el[8];
#pragma unroll
      for (int ks = 0; ks < 2; ++ks) vf[ks] = *(const bf16x8*)(smem + HG_VT + (wid * 16 + fr) * 144 + (ks * 32 + fq * 8) * 2);
#pragma unroll
      for (int mt = 0; mt < 8; ++mt) {
#pragma unroll
        for (int ks = 0; ks < 2; ++ks) kfS[mt][ks] = *(const bf16x8*)(smem + HG_KTT + (mt * 16 + fr) * 144 + (ks * 32 + fq * 8) * 2);
        el[mt] = *(const f32x4*)(elast + mt * 16 + fq * 4);
      }
#pragma unroll
      for (int ks = 0; ks < 2; ++ks)
#pragma unroll
        for (int mt = 0; mt < 8; ++mt) S[mt] = __builtin_amdgcn_mfma_f32_16x16x32_bf16(kfS[mt][ks], vf[ks], S[mt], 0, 0, 0);
#pragma unroll
      for (int mt = 0; mt < 8; ++mt) S[mt] *= el[mt];
    }
    LDS_BARRIER();
    float pt[4][8];
#pragma unroll
    for (int tt = 0; tt < 4; ++tt)
#pragma unroll
      for (int w = 0; w < 8; ++w) pt[tt][w] = part[w * 64 + tt * 16 + fr];
#pragma unroll
    for (int tt = 0; tt < 4; ++tt) {
      const int t = tt * 16 + fr;
      float tot = 0.f;
#pragma unroll
      for (int w = 0; w < 8; ++w) tot += pt[tt][w];
      const float rs = rsqrtf(tot * (1.f / 128.f) + 1e-6f);
      const u32x2 gv = sgv[tt];
      f32x4 r;
      r[0] = o[tt][0] * rs * gain4[0] * __uint_as_float(gv[0] << 16);
      r[1] = o[tt][1] * rs * gain4[1] * __uint_as_float(gv[0] & 0xffff0000u);
      r[2] = o[tt][2] * rs * gain4[2] * __uint_as_float(gv[1] << 16);
      r[3] = o[tt][3] * rs * gain4[3] * __uint_as_float(gv[1] & 0xffff0000u);
      store_bf4(((bf16_t*)(ws_ + OFF_cc)) + (size_t)(t0 + t) * DM + h * 128 + wid * 16 + fq * 4, r);
    }
  }
  __syncthreads();
}

constexpr int AT_KSTRIDE = 400, AT_VSTRIDE = 144, AT_KBYTES = 64 * AT_KSTRIDE, AT_VBYTES = 128 * AT_VSTRIDE, AT_BUF = AT_KBYTES + AT_VBYTES;

__device__ __forceinline__ void attn_qblock(const Params& P, const int b, const int h, const int jq) {
  GCHAR* ws_ = (GCHAR*)P.ws; asm volatile("" : "+s"(ws_));
  const int tid = tid_l(), wid = tid >> 6, lane = tid & 63, fr = lane & 15, fq = lane >> 4;
  const int qpos0 = jq * 256 + wid * 32;
  const size_t tok0 = (size_t)b * SEQ;
  bf16x8 Qf[2][6];
#pragma unroll
  for (int qt = 0; qt < 2; ++qt)
#pragma unroll
    for (int ks = 0; ks < 6; ++ks)
      Qf[qt][ks] = *(const bf16x8*)(((bf16_t*)P.out) + (tok0 + qpos0 + qt * 16 + fr) * 768 + h * 192 + ks * 32 + fq * 8);
  f32x4 O[8][2];
#pragma unroll
  for (int i = 0; i < 8; ++i) { O[i][0] = (f32x4){0.f, 0.f, 0.f, 0.f}; O[i][1] = (f32x4){0.f, 0.f, 0.f, 0.f}; }
  float mrun[2] = {-INFINITY, -INFINITY}, lrun[2] = {0.f, 0.f};
  const int nkt = (jq + 1) * 4;
  int kkey[3], kch[3];
#pragma unroll
  for (int r = 0; r < 3; ++r) { const int i = tid + r * 512; kkey[r] = i / 24; kch[r] = i % 24; }
  const bf16_t* Kbase = ((bf16_t*)(ws_ + OFF_Kb)) + tok0 * 768 + h * 192;
  const bf16_t* Vbase = ((bf16_t*)(ws_ + OFF_Vt)) + (size_t)(b * 4 + h) * 128 * SEQ;
  u32x4 kreg[3], vreg[2];
#define AT_LOAD(kt_) do { \
    _Pragma("unroll") for (int r = 0; r < 3; ++r) kreg[r] = *(const u32x4*)(Kbase + (size_t)((kt_) * 64 + kkey[r]) * 768 + kch[r] * 8); \
    _Pragma("unroll") for (int r = 0; r < 2; ++r) { const int i = tid + r * 512; vreg[r] = *(const u32x4*)(Vbase + (size_t)(i >> 3) * SEQ + (kt_) * 64 + (i & 7) * 8); } } while (0)
#define AT_WRITE(buf_) do { char* bp = smem + (buf_) * AT_BUF; \
    _Pragma("unroll") for (int r = 0; r < 3; ++r) *(u32x4*)(bp + kkey[r] * AT_KSTRIDE + kch[r] * 16) = kreg[r]; \
    _Pragma("unroll") for (int r = 0; r < 2; ++r) { const int i = tid + r * 512; *(u32x4*)(bp + AT_KBYTES + (i >> 3) * AT_VSTRIDE + (i & 7) * 16) = vreg[r]; } } while (0)
  __syncthreads();
  AT_LOAD(0); AT_WRITE(0);
  __syncthreads();
  for (int kt = 0; kt < nkt; ++kt) {
    if (kt + 1 < nkt) AT_LOAD(kt + 1);
    const int kpos0 = kt * 64;
    if (kpos0 <= qpos0 + 31) {
      const char* kb = smem + (kt & 1) * AT_BUF;
      const char* vb = kb + AT_KBYTES;
      f32x4 s[4][2];
#pragma unroll
      for (int i = 0; i < 4; ++i) { s[i][0] = (f32x4){0.f, 0.f, 0.f, 0.f}; s[i][1] = (f32x4){0.f, 0.f, 0.f, 0.f}; }
      {
        bf16x8 kfa[2], kfb[2];
#define AT_LDK(dst, g_) _Pragma("unroll") for (int e = 0; e < 2; ++e) dst[e] = *(const bf16x8*)(kb + ((((g_) & 1) * 2 + e) * 16 + fr) * AT_KSTRIDE + (((g_) >> 1) * 32 + fq * 8) * 2)
#define AT_QK(src, g_) _Pragma("unroll") for (int e = 0; e < 2; ++e) { const int k4_ = ((g_) & 1) * 2 + e, ks_ = (g_) >> 1; \
          s[k4_][0] = __builtin_amdgcn_mfma_f32_16x16x32_bf16(src[e], Qf[0][ks_], s[k4_][0], 0, 0, 0); \
          s[k4_][1] = __builtin_amdgcn_mfma_f32_16x16x32_bf16(src[e], Qf[1][ks_], s[k4_][1], 0, 0, 0); }
        AT_LDK(kfa, 0);
#pragma unroll
        for (int g = 0; g < 12; g += 2) {
          AT_LDK(kfb, g + 1);
          __builtin_amdgcn_sched_barrier(0);
          __builtin_amdgcn_s_setprio(1);
          AT_QK(kfa, g);
          __builtin_amdgcn_s_setprio(0);
          __builtin_amdgcn_sched_barrier(0);
          if (g + 2 < 12) { AT_LDK(kfa, g + 2); }
          __builtin_amdgcn_sched_barrier(0);
          __builtin_amdgcn_s_setprio(1);
          AT_QK(kfb, g + 1);
          __builtin_amdgcn_s_setprio(0);
          __builtin_amdgcn_sched_barrier(0);
        }
#undef AT_LDK
#undef AT_QK
      }
      __builtin_amdgcn_s_setprio(0);
      if (kpos0 + 63 > qpos0) {
#pragma unroll
        for (int k4 = 0; k4 < 4; ++k4)
#pragma unroll
          for (int qt = 0; qt < 2; ++qt)
#pragma unroll
            for (int j = 0; j < 4; ++j)
              if (kpos0 + k4 * 16 + fq * 4 + j > qpos0 + qt * 16 + fr) s[k4][qt][j] = -INFINITY;
      }
      bf16x8 Pf[2][2];
#pragma unroll
      for (int qt = 0; qt < 2; ++qt) {
        float mx = -INFINITY;
#pragma unroll
        for (int k4 = 0; k4 < 4; ++k4)
#pragma unroll
          for (int j = 0; j < 4; ++j) mx = fmaxf(mx, s[k4][qt][j]);
        mx = fmaxf(mx, __shfl_xor(mx, 16)); mx = fmaxf(mx, __shfl_xor(mx, 32));
        const float mnew = fmaxf(mrun[qt], mx);
        const float alpha = __builtin_amdgcn_exp2f(mrun[qt] - mnew);
        mrun[qt] = mnew;
        float ps = 0.f;
#pragma unroll
        for (int k4 = 0; k4 < 4; ++k4)
#pragma unroll
          for (int j = 0; j < 4; ++j) { const float pv = __builtin_amdgcn_exp2f(s[k4][qt][j] - mnew); s[k4][qt][j] = pv; ps += pv; }
        lrun[qt] = lrun[qt] * alpha + ps;
#pragma unroll
        for (int dvt = 0; dvt < 8; ++dvt) O[dvt][qt] *= alpha;
#pragma unroll
        for (int kp = 0; kp < 2; ++kp) {
          u32x4 pu = {cvt_pk(s[2 * kp][qt][0], s[2 * kp][qt][1]), cvt_pk(s[2 * kp][qt][2], s[2 * kp][qt][3]),
                      cvt_pk(s[2 * kp + 1][qt][0], s[2 * kp + 1][qt][1]), cvt_pk(s[2 * kp + 1][qt][2], s[2 * kp + 1][qt][3])};
          Pf[qt][kp] = __builtin_bit_cast(bf16x8, pu);
        }
      }
      {
        bf16x8 va[2], vbq[2];
#define AT_LDV(dst, g_) _Pragma("unroll") for (int e = 0; e < 2; ++e) { const int dvt_ = (g_), kp_ = e; \
          const u32x2 v0 = *(const u32x2*)(vb + (dvt_ * 16 + fr) * AT_VSTRIDE + ((2 * kp_) * 16 + fq * 4) * 2); \
          const u32x2 v1 = *(const u32x2*)(vb + (dvt_ * 16 + fr) * AT_VSTRIDE + ((2 * kp_ + 1) * 16 + fq * 4) * 2); \
          u32x4 vu = {v0[0], v0[1], v1[0], v1[1]}; dst[e] = __builtin_bit_cast(bf16x8, vu); }
#define AT_PV(src, g_) _Pragma("unroll") for (int e = 0; e < 2; ++e) { const int dvt_ = (g_), kp_ = e; \
          O[dvt_][0] = __builtin_amdgcn_mfma_f32_16x16x32_bf16(src[e], Pf[0][kp_], O[dvt_][0], 0, 0, 0); \
          O[dvt_][1] = __builtin_amdgcn_mfma_f32_16x16x32_bf16(src[e], Pf[1][kp_], O[dvt_][1], 0, 0, 0); }
        AT_LDV(va, 0);
#pragma unroll
        for (int g = 0; g < 8; g += 2) {
          AT_LDV(vbq, g + 1);
          __builtin_amdgcn_sched_barrier(0);
          __builtin_amdgcn_s_setprio(1);
          AT_PV(va, g);
          __builtin_amdgcn_s_setprio(0);
          __builtin_amdgcn_sched_barrier(0);
          if (g + 2 < 8) { AT_LDV(va, g + 2); }
          __builtin_amdgcn_sched_barrier(0);
          __builtin_amdgcn_s_setprio(1);
          AT_PV(vbq, g + 1);
          __builtin_amdgcn_s_setprio(0);
          __builtin_amdgcn_sched_barrier(0);
        }
#undef AT_LDV
#undef AT_PV
      }
    }
    __builtin_amdgcn_s_setprio(0);
    if (kt + 1 < nkt) AT_WRITE((kt + 1) & 1);
    __syncthreads();
  }
#pragma unroll
  for (int qt = 0; qt < 2; ++qt) {
    float l = lrun[qt];
    l += __shfl_xor(l, 16); l += __shfl_xor(l, 32);
    const float inv = 1.f / l;
    bf16_t* dst = ((bf16_t*)(ws_ + OFF_cc)) + (tok0 + qpos0 + qt * 16 + fr) * DM + 512 + h * 128 + fq * 4;
#pragma unroll
    for (int dvt = 0; dvt < 8; ++dvt) store_bf4(dst + dvt * 16, O[dvt][qt] * inv);
  }
#undef AT_LOAD
#undef AT_WRITE
}


__device__ __forceinline__ void hgrn_dbg(const Params& P, const int bh) {
  GCHAR* ws_ = (GCHAR*)P.ws; asm volatile("" : "+s"(ws_));
  const int b = bh >> 2, h = bh & 3, tid = tid_l();
  for (int i = tid; i < SEQ * 128; i += 512) {
    const int t = b * SEQ + (i >> 7), d = i & 127;
    const float a = bf2f(((bf16_t*)(ws_ + OFF_sg))[(size_t)t * 512 + h * 128 + d]);
    const float q = bf2f(((bf16_t*)(ws_ + OFF_qh))[(size_t)t * 512 + h * 128 + d]);
    const float l = ((float*)(ws_ + OFF_logf))[(size_t)t * 512 + h * 128 + d];
    const float v = bf2f(((bf16_t*)(ws_ + OFF_vhT))[(size_t)(h * 128 + d) * T + t]);
    const unsigned o = cvt_pk(a * (q + l + v), 0.f);
    ((bf16_t*)(ws_ + OFF_cc))[(size_t)t * DM + h * 128 + d] = (bf16_t)(o & 0xffffu);
  }
}

__device__ __forceinline__ void phase_mix(const Params& P) {
  GCHAR* ws_ = (GCHAR*)P.ws; asm volatile("" : "+s"(ws_));
#ifndef DBG_SKIP_HGRN
  for (int it = blockIdx.x; it < 64; it += gridDim.x) hgrn_item(P, it);
#endif
  int* slot = (int*)(smem + LDS_STAGE + 16);
  const int tid = tid_l();
  for (;;) {
    __syncthreads();
    if (tid == 0) *slot = (int)atomicAdd((unsigned*)(ws_ + OFF_ctr), 1u);
    __syncthreads();
    const int it = *(volatile int*)slot;
    if (it >= 512) break;
    const int jq = 7 - (it >> 6), bh = it & 63;
    attn_qblock(P, bh >> 2, bh & 3, jq);
  }
}

__device__ __forceinline__ void phase_final(const Params& P) {
  GCHAR* ws_ = (GCHAR*)P.ws; asm volatile("" : "+s"(ws_));
  const int tid = tid_l(), lane = tid & 63, wid = tid >> 6;
  for (int row = blockIdx.x * 8 + wid; row < T; row += gridDim.x * 8) {
    const float rs = rsqrtf(((float*)(ws_ + OFF_ssq5))[row] * (1.f / 1024.f) + 1e-6f);
#pragma unroll
    for (int i = 0; i < 2; ++i) {
      const int col = i * 512 + lane * 8;
      const u32x4 hv = *(const u32x4*)(((const bf16_t*)(ws_ + OFF_cc)) + (size_t)row * DM + col);
      const f32x4 g0 = *(const f32x4*)(P.ln_final + col), g1 = *(const f32x4*)(P.ln_final + col + 4);
      f32x4 y0, y1;
      y0[0] = __uint_as_float(hv[0] << 16); y0[1] = __uint_as_float(hv[0] & 0xffff0000u); y0[2] = __uint_as_float(hv[1] << 16); y0[3] = __uint_as_float(hv[1] & 0xffff0000u);
      y1[0] = __uint_as_float(hv[2] << 16); y1[1] = __uint_as_float(hv[2] & 0xffff0000u); y1[2] = __uint_as_float(hv[3] << 16); y1[3] = __uint_as_float(hv[3] & 0xffff0000u);
      *(f32x4*)(P.out + (size_t)row * DM + col) = y0 * rs * g0;
      *(f32x4*)(P.out + (size_t)row * DM + col + 4) = y1 * rs * g1;
    }
  }
}


#define XB_TMO      128
#define XB_XCNT(j)  (256  + 64 * (j))
#define XB_XSUB(j)  (1280 + 64 * (j))
#define XB_XGEN(j)  (2304 + 64 * (j))
#define XB_TOP      3328
#define XB_TOPGEN   3392
#define XCD_BAR_WORDS 3456
#define XB_SPIN_CAP (1u << 18)
#define XLAS __attribute__((address_space(3)))
__device__ __forceinline__ unsigned xb_ld(unsigned* p)              { return __hip_atomic_load(p, __ATOMIC_RELAXED, __HIP_MEMORY_SCOPE_AGENT); }
__device__ __forceinline__ unsigned xb_add(unsigned* p, unsigned v) { return __hip_atomic_fetch_add(p, v, __ATOMIC_RELAXED, __HIP_MEMORY_SCOPE_AGENT); }
__device__ __forceinline__ unsigned xb_xcc_id() { return (unsigned)__builtin_amdgcn_s_getreg((3 << 11) | 20) & 0xFu; }
#define XB_SPIN(cond, bar) do { unsigned _sp = 0; while (cond) { __builtin_amdgcn_s_sleep(1); \
    if ((++_sp & 255u) == 0u) { if (xb_ld(&(bar)[XB_TMO])) break; if (_sp > XB_SPIN_CAP) { atomicAdd(&(bar)[XB_TMO], 1u); break; } } } } while (0)
struct XcdBarrier { unsigned* bar; unsigned x; volatile XLAS unsigned* st; };
__device__ __forceinline__ XcdBarrier xcd_barrier_post(unsigned* bar, volatile XLAS unsigned* st) {
  XcdBarrier b; b.bar = bar; b.x = xb_xcc_id(); b.st = st;
  if (threadIdx.x == 0) (void)xb_add(&bar[XB_XCNT(b.x)], 1u);
  return b;
}
__device__ __forceinline__ void xcd_barrier_complete(unsigned* bar, unsigned x, unsigned& nloc, unsigned& nx) {
  const unsigned G = gridDim.x * gridDim.y * gridDim.z;
  unsigned sum, cnt, mine, sp = 0u;
  for (;;) {
    sum = 0u; cnt = 0u; mine = 0u;
#pragma unroll
    for (unsigned j = 0; j < 16; ++j) { const unsigned c = xb_ld(&bar[XB_XCNT(j)]); sum += c; cnt += (c > 0u) ? 1u : 0u; mine = (j == x) ? c : mine; }
    if (sum == G) break;
    __builtin_amdgcn_s_sleep(1);
    if ((++sp & 255u) == 0u) { if (xb_ld(&bar[XB_TMO])) break; if (sp > XB_SPIN_CAP) { atomicAdd(&bar[XB_TMO], 1u); break; } }
  }
  nloc = mine > 0u ? mine : 1u; nx = cnt > 0u ? cnt : 1u;
}
__device__ __forceinline__ void xcd_barrier(const XcdBarrier& b) {
  asm volatile("s_waitcnt vmcnt(0)" ::: "memory");
  __syncthreads();
  if (threadIdx.x == 0) {
    unsigned* bar = b.bar;
    __builtin_amdgcn_s_waitcnt(0);
    unsigned nloc = b.st[0], nx = b.st[1];
    if (nloc == 0u) { xcd_barrier_complete(bar, b.x, nloc, nx); b.st[0] = nloc; b.st[1] = nx; }
    const unsigned old = xb_add(&bar[XB_XSUB(b.x)], 1u);
    const unsigned gen = old / nloc;
    if (old + 1u == (gen + 1u) * nloc) {
      __builtin_amdgcn_fence(__ATOMIC_RELEASE, "agent");
      asm volatile("s_waitcnt vmcnt(0)" ::: "memory");
      const unsigned og = xb_add(&bar[XB_TOP], 1u);
      const unsigned tg = og / nx;
      if (og + 1u == (tg + 1u) * nx) xb_add(&bar[XB_TOPGEN], 1u);
      else XB_SPIN(xb_ld(&bar[XB_TOPGEN]) == tg, bar);
      __builtin_amdgcn_fence(__ATOMIC_ACQUIRE, "agent");
      xb_add(&bar[XB_XGEN(b.x)], 1u);
      asm volatile("s_waitcnt vmcnt(0)" ::: "memory");
    } else {
      XB_SPIN(xb_ld(&bar[XB_XGEN(b.x)]) == gen, bar);
      __builtin_amdgcn_fence(__ATOMIC_ACQUIRE, "agent");
      asm volatile("s_waitcnt vmcnt(0)" ::: "memory");
    }
  }
  __syncthreads();
}

__global__ void __launch_bounds__(512) mega(const Params P) {
  cg::grid_group grid = cg::this_grid();
  volatile XLAS unsigned* xst = (volatile XLAS unsigned*)(smem + LDS_STAGE);
  if (threadIdx.x == 0) { xst[0] = 0u; xst[1] = 0u; }
  __syncthreads();
  const XcdBarrier xbar = xcd_barrier_post((unsigned*)(P.ws + OFF_bar), xst);
  const GemmJob none = mkjob(nullptr, nullptr, 0, 0, 0, 0);
  for (int step = P.ph_lo; step < P.ph_hi; ++step) {
    const int ph = (PROBE_REP >= 0 && step > PROBE_REP) ? step - 1 : step;
    if (step > P.ph_lo) { if (P.ph_hi > 1000) grid.sync(); else xcd_barrier(xbar); }
    GCHAR* ws_ = (GCHAR*)P.ws; asm volatile("" : "+s"(ws_));
    if (ph == 0) { phase0(P); continue; }
#ifdef DBG_SKIP_MIX
    if (ph == 5) continue;
#else
    if (ph == 5) { phase_mix(P); continue; }
#endif
    if (ph == 10) { phase_final(P); continue; }
    if (ph == 6) {
      gemm_phase(P, mkjob(((bf16_t*)(ws_ + OFF_cc)), ((bf16_t*)(ws_ + OFF_Woutt)), 1024, 4, M_RESID, 1), none);
      __syncthreads();
      gemm_phase(P, mkjob(((bf16_t*)(ws_ + OFF_pb)), ((bf16_t*)(ws_ + OFF_Wppt)), 256, 4, M_PP, 0), none);
      continue;
    }
    GemmJob j0 = none, j1 = none;
    switch (ph) {
      case 1: j0 = mkjob(((bf16_t*)(ws_ + OFF_hb)), ((bf16_t*)(ws_ + OFF_W1cat)), 1024, 22, M_SWIGLU, 0); break;
      case 2: j0 = mkjob(((bf16_t*)(ws_ + OFF_act)), ((bf16_t*)(ws_ + OFF_Wd1t)), 2816, 4, M_RESID, 0); break;
      case 3: j0 = mkjob(((bf16_t*)(ws_ + OFF_hb)), ((bf16_t*)(ws_ + OFF_Wint)), 1024, 10, M_WIN, 0); break;
      case 4: j0 = mkjob(((bf16_t*)(ws_ + OFF_cqb)), ((bf16_t*)(ws_ + OFF_Wqt)), 256, 3, M_QUP, 0); j1 = mkjob(((bf16_t*)(ws_ + OFF_ckvb)), ((bf16_t*)(ws_ + OFF_Wkvt)), 256, 4, M_KVUP, 0); break;
      case 7: j0 = mkjob(((bf16_t*)(ws_ + OFF_hb)), ((bf16_t*)(ws_ + OFF_W2cat)), 1024, 22, M_SWIGLU, 1); break;
      case 8: j0 = mkjob(((bf16_t*)(ws_ + OFF_act)), ((bf16_t*)(ws_ + OFF_Wd2t)), 2816, 4, M_RESID, 2); break;
      default: j0 = mkjob(((bf16_t*)(ws_ + OFF_hb)), ((bf16_t*)(ws_ + OFF_Wpgt)), 1024, 4, M_PLE, 0); break;
    }
    gemm_phase(P, j0, j1);
    if (ph == 4) {
      hgrn_prepass(P);
    }
  }
}

extern "C" void kernel_launch(void* const* d_in, const int* in_sizes, int n_in, void* d_out, int out_size, void* d_ws, size_t ws_size, hipStream_t stream) {
  static int grid_blocks = 0;
  if (!grid_blocks) {
    int dev = 0, cus = 0, per_cu = 0;
    hipGetDevice(&dev);
    hipDeviceGetAttribute(&cus, hipDeviceAttributeMultiprocessorCount, dev);
    hipFuncSetAttribute((const void*)mega, hipFuncAttributeMaxDynamicSharedMemorySize, LDS_BYTES);
    hipOccupancyMaxActiveBlocksPerMultiprocessor(&per_cu, (const void*)mega, 512, LDS_BYTES);
    if (per_cu < 1) { fprintf(stderr, "occupancy query returned %d\n", per_cu); per_cu = 1; }
    grid_blocks = cus * per_cu;
    if (grid_blocks > 256) grid_blocks = 256;
  }
  Params P{};
  const float* const* in = (const float* const*)d_in;
  P.x = in[0]; P.p = in[1]; P.pos = (const int*)d_in[2];
  P.ln_ffn1 = in[3]; P.w1g = in[4]; P.w1u = in[5]; P.w1d = in[6]; P.ln_mix = in[7]; P.w_in = in[8]; P.lb_logits = in[9]; P.hg_norm = in[10];
  P.q_a_norm = in[11]; P.w_q_up = in[12]; P.kv_a_norm = in[13]; P.w_kv_up = in[14]; P.w_out = in[15]; P.ln_ffn2 = in[16];
  P.w2g = in[17]; P.w2u = in[18]; P.w2d = in[19]; P.ln_ple = in[20]; P.w_pg = in[21]; P.w_pp = in[22]; P.ln_final = in[23];
  P.out = (float*)d_out;
  P.ws = (char*)d_ws;
  if ((size_t)WS_END > ws_size) { fprintf(stderr, "workspace too small: need %zu have %zu\n", (size_t)WS_END, ws_size); return; }
#ifndef N_LAUNCH
#define N_LAUNCH 1
#ifndef PROBE_REP
#define PROBE_REP -1
#endif
#endif
  (void)hipMemsetAsync((char*)d_ws + OFF_bar, 0, 16384, stream);
  for (int li = 0; li < N_LAUNCH; ++li) {
    P.ph_lo = (N_LAUNCH == 1) ? 0 : li; P.ph_hi = (N_LAUNCH == 1) ? 11 + (PROBE_REP >= 0 ? 1 : 0) : li + 1;
    void* args[] = {(void*)&P};
    hipError_t e = hipLaunchCooperativeKernel((const void*)mega, dim3(grid_blocks), dim3(512), args, LDS_BYTES, stream);
    if (e != hipSuccess) fprintf(stderr, "cooperative launch failed: %s (grid %d)\n", hipGetErrorString(e), grid_blocks);
  }
}
```
